# Optimizing an MI355X kernel written in HIP

```python
import math
import jax, jax.numpy as jnp
from jax import lax
import numpy as np

D_MODEL = 1024
BATCH = 8
SEQ = 2048
DEPTH = 1

GDN_HEADS = 8
GDN_DK = 128
GDN_DV = 128
GDN_CONV = 4
GDN_CHUNK = 64
DIFF_HEADS = 8
DIFF_DH = 64
Q_BLOCK = 128
D_FF = 2816
FFN_CONV = 3
NORM_EPS = 1e-6

GDN_QK = GDN_HEADS * GDN_DK
GDN_V = GDN_HEADS * GDN_DV
DIFF_QK = DIFF_HEADS * 2 * DIFF_DH
DIFF_V = DIFF_HEADS * 2 * DIFF_DH

kernel_name = "hybrid_gdn_diffattn_convffn_block"


def _in_widths():
    return (GDN_QK, GDN_QK, GDN_V, GDN_V, GDN_HEADS, GDN_HEADS,
            DIFF_QK, DIFF_QK, DIFF_V, D_MODEL, D_MODEL)


def rmsnorm(x, g):
    xf = x.astype(jnp.float32)
    y = xf * lax.rsqrt(jnp.mean(xf * xf, axis=-1, keepdims=True) + NORM_EPS)
    return (y * g.astype(jnp.float32)).astype(x.dtype)


def l2norm(x):
    xf = x.astype(jnp.float32)
    return xf * lax.rsqrt(jnp.sum(xf * xf, axis=-1, keepdims=True) + NORM_EPS)


def causal_dwconv(x, w):
    K = w.shape[0]
    S = x.shape[1]
    xp = jnp.pad(x, ((0, 0), (K - 1, 0), (0, 0)))
    y = xp[:, 0:S, :] * w[0]
    for j in range(1, K):
        y = y + xp[:, j:j + S, :] * w[j]
    return y


def gated_delta_rule_chunked(q, k, v, g, beta):
    B, H, S, dk = q.shape
    dv = v.shape[-1]
    C = GDN_CHUNK
    NC = S // C
    q = q.reshape(B, H, NC, C, dk) * (dk ** -0.5)
    k = k.reshape(B, H, NC, C, dk)
    v = v.reshape(B, H, NC, C, dv)
    g = g.reshape(B, H, NC, C)
    beta = beta.reshape(B, H, NC, C)

    gc = jnp.cumsum(g, axis=-1)
    diff = gc[..., :, None] - gc[..., None, :]
    incl = jnp.tril(jnp.ones((C, C), dtype=bool))
    strict = jnp.tril(jnp.ones((C, C), dtype=bool), k=-1)
    L = jnp.where(incl, jnp.exp(jnp.where(incl, diff, 0.0)), 0.0)

    kb = k * beta[..., None]
    vb = v * beta[..., None]
    A = jnp.where(strict, jnp.einsum('bhnid,bhnjd->bhnij', kb, k) * L, 0.0)
    eye = jnp.eye(C, dtype=A.dtype)
    rhs = jnp.concatenate([kb * jnp.exp(gc)[..., None], vb], axis=-1)
    wu = lax.linalg.triangular_solve(eye + A, rhs, left_side=True, lower=True,
                                     unit_diagonal=True)
    w, u = wu[..., :dk], wu[..., dk:]

    Aqk = jnp.where(incl, jnp.einsum('bhnid,bhnjd->bhnij', q, k) * L, 0.0)
    q_dec = q * jnp.exp(gc)[..., None]
    k_dec = k * jnp.exp(gc[..., -1:] - gc)[..., None]
    g_last = jnp.exp(gc[..., -1])

    def step(state, inp):
        w_c, u_c, qd_c, kd_c, aqk_c, gl_c = inp
        v_new = u_c - jnp.einsum('bhcd,bhde->bhce', w_c, state)
        o_c = (jnp.einsum('bhcd,bhde->bhce', qd_c, state)
               + jnp.einsum('bhij,bhje->bhie', aqk_c, v_new))
        state = state * gl_c[..., None, None] + jnp.einsum('bhcd,bhce->bhde', kd_c, v_new)
        return state, o_c

    xs = tuple(jnp.moveaxis(t, 2, 0) for t in (w, u, q_dec, k_dec, Aqk, g_last))
    state0 = jnp.zeros((B, H, dk, dv), dtype=jnp.float32)
    _, o = lax.scan(step, state0, xs)
    return jnp.moveaxis(o, 0, 2).reshape(B, H, S, dv)


def diff_attention(q, k, v, lam):
    B, S, H, _, dh = q.shape
    NB = S // Q_BLOCK
    scale = dh ** -0.5
    qb = q.astype(jnp.float32).reshape(B, NB, Q_BLOCK, H, 2, dh)
    qb = jnp.transpose(qb, (1, 0, 3, 4, 2, 5))
    kt = jnp.transpose(k.astype(jnp.float32), (0, 2, 3, 1, 4))
    vt = jnp.transpose(v.astype(jnp.float32), (0, 2, 1, 3))
    kpos = jnp.arange(S)
    neg = jnp.finfo(jnp.float32).min

    def one_block(args):
        q_blk, bi = args
        s = jnp.einsum('bhtqd,bhtkd->bhtqk', q_blk, kt) * scale
        qpos = bi * Q_BLOCK + jnp.arange(Q_BLOCK)
        mask = kpos[None, :] <= qpos[:, None]
        p = jax.nn.softmax(jnp.where(mask, s, neg), axis=-1)
        a = p[:, :, 0] - lam * p[:, :, 1]
        return jnp.einsum('bhqk,bhke->bhqe', a, vt)

    out = lax.map(one_block, (qb, jnp.arange(NB)))
    out = jnp.transpose(out, (1, 0, 3, 2, 4))
    return out.reshape(B, S, H, 2 * dh)


def hybrid_mixer(h, w_in, conv_qkv_w, A_log, dt_bias, gdn_out_norm,
                 lambda_q1, lambda_k1, lambda_q2, lambda_k2, diff_subln,
                 w_branch_gdn, w_branch_diff, w_out, lambda_init):
    B, S, _ = h.shape
    proj = h @ w_in
    idx = np.cumsum(np.array(_in_widths()))[:-1]
    gq, gk, gv, gz, ga, gb, dq, dk, dv, gate_gdn, gate_diff = jnp.split(proj, idx, axis=-1)

    qkv = jax.nn.silu(causal_dwconv(jnp.concatenate([gq, gk, gv], axis=-1), conv_qkv_w))
    q, k, v = jnp.split(qkv, [GDN_QK, 2 * GDN_QK], axis=-1)
    q = jnp.transpose(l2norm(q.reshape(B, S, GDN_HEADS, GDN_DK)), (0, 2, 1, 3))
    k = jnp.transpose(l2norm(k.reshape(B, S, GDN_HEADS, GDN_DK)), (0, 2, 1, 3))
    v = jnp.transpose(v.reshape(B, S, GDN_HEADS, GDN_DV).astype(jnp.float32), (0, 2, 1, 3))
    g = -jnp.exp(A_log.astype(jnp.float32)) * jax.nn.softplus(
        ga.astype(jnp.float32) + dt_bias.astype(jnp.float32))
    beta = jax.nn.sigmoid(gb.astype(jnp.float32))
    o = gated_delta_rule_chunked(q, k, v, jnp.transpose(g, (0, 2, 1)),
                                 jnp.transpose(beta, (0, 2, 1)))
    o = jnp.transpose(o, (0, 2, 1, 3))
    o = rmsnorm(o, gdn_out_norm) * jax.nn.silu(
        gz.reshape(B, S, GDN_HEADS, GDN_DV).astype(jnp.float32))
    o_gdn = o.reshape(B, S, GDN_V).astype(h.dtype)

    lam = (jnp.exp(jnp.sum(lambda_q1.astype(jnp.float32) * lambda_k1.astype(jnp.float32)))
           - jnp.exp(jnp.sum(lambda_q2.astype(jnp.float32) * lambda_k2.astype(jnp.float32)))
           + lambda_init)
    a = diff_attention(dq.reshape(B, S, DIFF_HEADS, 2, DIFF_DH),
                       dk.reshape(B, S, DIFF_HEADS, 2, DIFF_DH),
                       dv.reshape(B, S, DIFF_HEADS, 2 * DIFF_DH), lam)
    a = rmsnorm(a, diff_subln) * (1.0 - lambda_init)
    o_diff = a.reshape(B, S, DIFF_V).astype(h.dtype)

    merged = (jax.nn.sigmoid(gate_gdn) * (o_gdn @ w_branch_gdn)
              + jax.nn.sigmoid(gate_diff) * (o_diff @ w_branch_diff))
    return merged @ w_out


def conv_ffn(h, w_up, conv_w, conv_b, w_down):
    u = causal_dwconv(h @ w_up, conv_w) + conv_b
    gate, up = jnp.split(u, 2, axis=-1)
    return (jax.nn.silu(gate) * up) @ w_down


def setup_inputs(seed: int = 0) -> dict:
    key = jax.random.key(seed)
    ks = jax.random.split(key, 24)
    f32 = jnp.float32
    d_in = sum(_in_widths())

    def nrm(k, shape, scale):
        return jax.random.normal(k, shape, f32) * scale

    def gain(k, n):
        return 1.0 + 0.05 * jax.random.normal(k, (DEPTH, n), f32)

    dt = jnp.exp(jax.random.uniform(ks[5], (DEPTH, GDN_HEADS), f32,
                                    math.log(1e-3), math.log(1e-1)))
    return {
        "x": nrm(ks[0], (BATCH, SEQ, D_MODEL), 1.0),
        "norm_mix_pre": gain(ks[1], D_MODEL),
        "w_in": nrm(ks[2], (DEPTH, D_MODEL, d_in), D_MODEL ** -0.5),
        "conv_qkv_w": nrm(ks[3], (DEPTH, GDN_CONV, 2 * GDN_QK + GDN_V), GDN_CONV ** -0.5),
        "gdn_A_log": jnp.log(jax.random.uniform(ks[4], (DEPTH, GDN_HEADS), f32, 1.0, 16.0)),
        "gdn_dt_bias": dt + jnp.log(-jnp.expm1(-dt)),
        "gdn_out_norm": gain(ks[6], GDN_DV),
        "lambda_q1": nrm(ks[7], (DEPTH, DIFF_DH), 0.1),
        "lambda_k1": nrm(ks[8], (DEPTH, DIFF_DH), 0.1),
        "lambda_q2": nrm(ks[9], (DEPTH, DIFF_DH), 0.1),
        "lambda_k2": nrm(ks[10], (DEPTH, DIFF_DH), 0.1),
        "diff_subln": gain(ks[11], 2 * DIFF_DH),
        "w_branch_gdn": nrm(ks[12], (DEPTH, GDN_V, D_MODEL), GDN_V ** -0.5),
        "w_branch_diff": nrm(ks[13], (DEPTH, DIFF_V, D_MODEL), DIFF_V ** -0.5),
        "w_out": nrm(ks[14], (DEPTH, D_MODEL, D_MODEL), D_MODEL ** -0.5),
        "norm_mix_post": gain(ks[15], D_MODEL),
        "norm_ffn_pre": gain(ks[16], D_MODEL),
        "w_up": nrm(ks[17], (DEPTH, D_MODEL, 2 * D_FF), D_MODEL ** -0.5),
        "ffn_conv_w": nrm(ks[18], (DEPTH, FFN_CONV, 2 * D_FF), FFN_CONV ** -0.5),
        "ffn_conv_b": nrm(ks[19], (DEPTH, 2 * D_FF), 0.02),
        "w_down": nrm(ks[20], (DEPTH, D_FF, D_MODEL), D_FF ** -0.5),
        "norm_ffn_post": gain(ks[21], D_MODEL),
    }


def reference(x, norm_mix_pre, w_in, conv_qkv_w, gdn_A_log, gdn_dt_bias, gdn_out_norm,
              lambda_q1, lambda_k1, lambda_q2, lambda_k2, diff_subln,
              w_branch_gdn, w_branch_diff, w_out, norm_mix_post,
              norm_ffn_pre, w_up, ffn_conv_w, ffn_conv_b, w_down, norm_ffn_post):
    for l in range(DEPTH):
        lambda_init = 0.8 - 0.6 * math.exp(-0.3 * l)
        h = rmsnorm(x, norm_mix_pre[l])
        m = hybrid_mixer(h, w_in[l], conv_qkv_w[l], gdn_A_log[l], gdn_dt_bias[l],
                         gdn_out_norm[l], lambda_q1[l], lambda_k1[l], lambda_q2[l],
                         lambda_k2[l], diff_subln[l], w_branch_gdn[l], w_branch_diff[l],
                         w_out[l], lambda_init)
        x = x + rmsnorm(m, norm_mix_post[l])
        h = rmsnorm(x, norm_ffn_pre[l])
        f = conv_ffn(h, w_up[l], ffn_conv_w[l], ffn_conv_b[l], w_down[l])
        x = x + rmsnorm(f, norm_ffn_post[l])
    return x
```

```cpp
#include <hip/hip_runtime.h>
#include <hip/hip_cooperative_groups.h>
#include <cstdio>
#include <cstdint>

namespace pg8 {
#define PG8_LAS __attribute__((address_space(3)))
typedef unsigned short bf16_t;
typedef short bf16x8 __attribute__((ext_vector_type(8)));
typedef float f32x4 __attribute__((ext_vector_type(4)));
typedef unsigned u32x4 __attribute__((ext_vector_type(4)));
constexpr int BM = 256, BK = 64, HALF = 128, HTB = HALF * BK * 2  , STAGE_BYTES = 8 * HTB, NXCD = 8, WGM = 8;

__host__ __device__ __forceinline__ int lds_byte(int r, int c) { const int st = (r >> 4) * 2 + (c >> 5), rr = r & 15, cc = c & 31, ob = rr * 64 + cc * 2; return st * 1024 + (ob ^ (((ob >> 9) & 1) << 5)); }
__host__ __device__ __forceinline__ void stage_rc(int b, int& R, int& C) { const int st = b / 1024, sb = b % 1024, swz = sb ^ (((sb >> 9) & 1) << 5); R = (st >> 1) * 16 + swz / 64; C = (st & 1) * 32 + (swz % 64) / 2; }
__host__ __device__ __forceinline__ int perm32(int rho) { const int n = rho >> 4, i = rho & 15; return 8 * (i >> 2) + 4 * n + (i & 3); }

struct Unit { int pm, pn; };
struct Gemm { const bf16_t* A; const bf16_t* Bt; int M, N, K; size_t a_tstep; };

struct StaticOrder {
    int nM, nN, nwg, G, c;
    __host__ __device__ void init(int M, int N, int G_, int c_) { nM = M / BM; nN = N / BM; nwg = nM * nN; G = G_; c = c_; }
    __host__ __device__ bool next(int i, Unit& u) const {
        const long L = (long)i * G + c; if (L >= nwg) return false;
        int wgid = (int)L; { const int q = nwg / NXCD, r = nwg % NXCD, xcd = wgid % NXCD, off = wgid / NXCD; wgid = (xcd < r ? xcd * (q + 1) : r * (q + 1) + (xcd - r) * q) + off; }
        const int nig = WGM * nN, gid = wgid / nig, fm = gid * WGM, gsz = (nM - fm) < WGM ? (nM - fm) : WGM;
        u.pm = fm + ((wgid % nig) % gsz); u.pn = (wgid % nig) / gsz; return true;
    }
    __device__ __forceinline__ void a_ready(const Unit&) const {}
    __device__ __forceinline__ void done(const Unit&) const {}
};

__device__ __forceinline__ unsigned cvt_pk_bf16(float lo, float hi) { unsigned r; asm volatile("v_cvt_pk_bf16_f32 %0, %1, %2" : "=v"(r) : "v"(lo), "v"(hi)); return r; }
typedef float f32x2 __attribute__((ext_vector_type(2)));
__device__ __forceinline__ f32x2 gelu_pk(f32x2 v) {
    const f32x2 av = __builtin_elementwise_abs(v), d = av * 0.2316418882f + 1.0f;
    f32x2 t; t.x = __builtin_amdgcn_rcpf(d.x); t.y = __builtin_amdgcn_rcpf(d.y);
    f32x2 q = t * 0.5307027145f + (-0.7265760135f); q = q * t + 0.7107068705f; q = q * t + (-0.142248368f); q = q * t + 0.127414796f; q = q * t;
    const f32x2 s = (v * v) * (-0.72134752044f);
    f32x2 e; e.x = __builtin_amdgcn_exp2f(s.x); e.y = __builtin_amdgcn_exp2f(s.y);
    const f32x2 m = v * (q * e), r = v - m;
    f32x2 o; o.x = v.x < 0.f ? m.x : r.x; o.y = v.y < 0.f ? m.y : r.y; return o;
}

template <int ACT  > struct EpiBf16 {
    static constexpr bool PERM = true, AFTER_DRAIN = false; static_assert(ACT == 0 || ACT == 1, "EpiBf16: ACT is 0 (none) or 1 (gelu_pk)");
    bf16_t* O; int ldc; const float* bias; int split_cols; size_t split_stride; float scale0;
    __device__ __forceinline__ void operator()(const f32x4 (&acc)[2][2][4][2], const Unit& u, int wr, int wc, int fr, int fq) const {
        const int row0 = u.pm * BM + wr * 64 + fr; int colt = u.pn * BM; bf16_t* base = O;
        float sc = 1.f; if (split_cols) { const int t = colt / split_cols; base += (size_t)t * split_stride; colt -= t * split_cols; if (t == 0) sc = scale0; }
        const int col0 = colt + wc * 32 + 8 * fq, bcol0 = u.pn * BM + wc * 32 + 8 * fq;
        f32x4 bv[2][2];
#pragma unroll
        for (int bj = 0; bj < 2; ++bj)
#pragma unroll
            for (int n = 0; n < 2; ++n) bv[bj][n] = bias ? *(const f32x4*)(bias + bcol0 + bj * HALF + 4 * n) : (f32x4){0.f, 0.f, 0.f, 0.f};
#pragma unroll
        for (int ai = 0; ai < 2; ++ai)
#pragma unroll
            for (int m = 0; m < 4; ++m) { bf16_t* rowp = base + (size_t)(row0 + ai * HALF + m * 16) * ldc + col0;
#pragma unroll
                for (int bj = 0; bj < 2; ++bj) { f32x4 v0 = acc[ai][bj][m][0] + bv[bj][0], v1 = acc[ai][bj][m][1] + bv[bj][1];
                    if (ACT == 1) { f32x2 a = gelu_pk((f32x2){v0[0], v0[1]}), b = gelu_pk((f32x2){v0[2], v0[3]}), c = gelu_pk((f32x2){v1[0], v1[1]}), d = gelu_pk((f32x2){v1[2], v1[3]});
                        v0 = (f32x4){a.x, a.y, b.x, b.y}; v1 = (f32x4){c.x, c.y, d.x, d.y}; }
                    v0 = v0 * sc; v1 = v1 * sc; u32x4 w; w.x = cvt_pk_bf16(v0[0], v0[1]); w.y = cvt_pk_bf16(v0[2], v0[3]); w.z = cvt_pk_bf16(v1[0], v1[1]); w.w = cvt_pk_bf16(v1[2], v1[3]);
                    *(u32x4*)(rowp + bj * HALF) = w; } }
    }
};
template <class Epi, class Sched, bool ALIGN_EPI = false, bool SP2 = false>
__device__ __forceinline__ void gemm_phase(PG8_LAS unsigned char* lds, const Gemm g, const Sched& S, const Epi& E) {
    const int tid = threadIdx.x, wid = __builtin_amdgcn_readfirstlane(tid >> 6), lane = tid & 63, wr = wid >> 2, wc = wid & 3, fr = lane & 15, fq = lane >> 4;
    const int K = g.K, nt = K / BK;
    unsigned voffA[2], voffB[2];
#pragma unroll
    for (int i = 0; i < 2; ++i) { int R, C; stage_rc(tid * 16 + i * 8192, R, C); const int Rb = Epi::PERM ? ((R & ~31) + perm32(R & 31)) : R;
        voffA[i] = (unsigned)(R * K + C) * 2u; voffB[i] = (unsigned)(Rb * K + C) * 2u; }
    const size_t kstep = (size_t)(BK * 2);
    const size_t hstep = (size_t)HALF * K * 2;
    const size_t tstep = 2 * hstep;
    const size_t tstepA = g.a_tstep ? g.a_tstep : tstep;
    const unsigned ldsw = (unsigned)wid * 1024u;
    const int aoff = lds_byte(wr * 64 + fr, fq * 8), boff = lds_byte(wc * 32 + fr, fq * 8);
#define PG8_SA(b, h) (((b) * 2 + (h)) * HTB)
#define PG8_SB(b, h) ((4 + (b) * 2 + (h)) * HTB)
#define PG8_STAGE(bufoff, gbase, voff) do { _Pragma("unroll") for (int _i = 0; _i < 2; ++_i) \
        __builtin_amdgcn_global_load_lds((const unsigned*)((const char*)(gbase) + (voff)[_i]), (PG8_LAS unsigned*)(lds + (bufoff) + ldsw + _i * 8192), 16, 0, 0); } while (0)
#define PG8_LDA(dst, b, h) do { _Pragma("unroll") for (int m = 0; m < 4; ++m) _Pragma("unroll") for (int k = 0; k < 2; ++k) dst[m][k] = *(const PG8_LAS bf16x8*)(lds + PG8_SA(b, h) + aoff + m * 2048 + k * 1024); } while (0)
#define PG8_LDB(dst, b, h) do { _Pragma("unroll") for (int n = 0; n < 2; ++n) _Pragma("unroll") for (int k = 0; k < 2; ++k) dst[n][k] = *(const PG8_LAS bf16x8*)(lds + PG8_SB(b, h) + boff + n * 2048 + k * 1024); } while (0)
#define PG8_MMA(ai, bj, At, Bt) do { __builtin_amdgcn_s_setprio(1); _Pragma("unroll") for (int m = 0; m < 4; ++m) _Pragma("unroll") for (int n = 0; n < 2; ++n) _Pragma("unroll") for (int k = 0; k < 2; ++k) \
        acc[ai][bj][m][n] = __builtin_amdgcn_mfma_f32_16x16x32_bf16(Bt[n][k], At[m][k], acc[ai][bj][m][n], 0, 0, 0); __builtin_amdgcn_s_setprio(0); } while (0)
#define PG8_WAIT_V(n) asm volatile("s_waitcnt vmcnt(" #n ")" ::: "memory")
#define PG8_WAIT_L(n) asm volatile("s_waitcnt lgkmcnt(" #n ")" ::: "memory")
#define PG8_BAR __builtin_amdgcn_s_barrier()
#define PG8_SCHED __builtin_amdgcn_sched_barrier(0)
    Unit cur, nxt; int ui = 0;
    if (!S.next(0, cur)) return;
    f32x4 acc[2][2][4][2];
#pragma unroll
    for (int a = 0; a < 2; ++a)
#pragma unroll
        for (int b = 0; b < 2; ++b)
#pragma unroll
            for (int m = 0; m < 4; ++m)
#pragma unroll
                for (int n = 0; n < 2; ++n) acc[a][b][m][n] = (f32x4){0.f, 0.f, 0.f, 0.f};
    bf16x8 At[4][2], B0[2][2], B1[2][2];
    const char* cA = (const char*)g.A + (size_t)cur.pm * tstepA; const char* cB = (const char*)g.Bt + (size_t)cur.pn * tstep;
    S.a_ready(cur);
    if constexpr (SP2) {
        PG8_STAGE(PG8_SB(0, 0), cB, voffB); PG8_STAGE(PG8_SB(0, 1), cB + hstep, voffB); PG8_STAGE(PG8_SA(0, 0), cA, voffA); PG8_STAGE(PG8_SA(0, 1), cA + hstep, voffA);
        if (wr == 1) PG8_BAR;
        PG8_WAIT_V(2); PG8_BAR;
        PG8_STAGE(PG8_SB(1, 0), cB + kstep, voffB); PG8_STAGE(PG8_SA(1, 0), cA + kstep, voffA); PG8_STAGE(PG8_SB(1, 1), cB + hstep + kstep, voffB);
        PG8_WAIT_V(6); PG8_BAR;
    } else {
        PG8_STAGE(PG8_SB(0, 0), cB, voffB); PG8_STAGE(PG8_SA(0, 0), cA, voffA); PG8_STAGE(PG8_SB(0, 1), cB + hstep, voffB); PG8_STAGE(PG8_SA(0, 1), cA + hstep, voffA);
        if (wr == 1) PG8_BAR;
        PG8_WAIT_V(4); PG8_BAR;
        PG8_STAGE(PG8_SB(1, 0), cB + kstep, voffB); PG8_STAGE(PG8_SA(1, 0), cA + kstep, voffA); PG8_STAGE(PG8_SB(1, 1), cB + hstep + kstep, voffB);
        PG8_WAIT_V(6); PG8_BAR;
    }
    for (;;) {
        const bool has_next = S.next(ui + 1, nxt);
        const char* nA = has_next ? (const char*)g.A + (size_t)nxt.pm * tstepA : cA; const char* nB = has_next ? (const char*)g.Bt + (size_t)nxt.pn * tstep : cB;
        for (int t = 0; t < nt; t += 2) {
            const bool last = (t == nt - 2);
            const char* a1 = cA + (size_t)(t + 1) * kstep;
            const char* a2 = last ? nA : cA + (size_t)(t + 2) * kstep; const char* b2 = last ? nB : cB + (size_t)(t + 2) * kstep;
            const char* a3 = a2 + kstep; const char* b3 = b2 + kstep;
            if (last && has_next) S.a_ready(nxt);
            if constexpr (SP2) {
            PG8_LDB(B0, 0, 0); PG8_LDB(B1, 0, 1); PG8_SCHED; PG8_LDA(At, 0, 0); PG8_STAGE(PG8_SA(1, 1), a1 + hstep, voffA);
            PG8_WAIT_V(8); PG8_WAIT_L(0); PG8_BAR; PG8_MMA(0, 0, At, B0); PG8_MMA(0, 1, At, B1); PG8_BAR; PG8_SCHED;
            PG8_LDA(At, 0, 1); PG8_STAGE(PG8_SB(0, 0), b2, voffB); PG8_STAGE(PG8_SB(0, 1), b2 + hstep, voffB); PG8_STAGE(PG8_SA(0, 0), a2, voffA);
            PG8_WAIT_V(8); PG8_WAIT_L(0); PG8_BAR; PG8_MMA(1, 0, At, B0); PG8_MMA(1, 1, At, B1); PG8_BAR; PG8_SCHED;
            PG8_LDB(B0, 1, 0); PG8_LDB(B1, 1, 1); PG8_SCHED; PG8_LDA(At, 1, 0); PG8_STAGE(PG8_SA(0, 1), a2 + hstep, voffA);
            PG8_WAIT_V(8); PG8_WAIT_L(0); PG8_BAR; PG8_MMA(0, 0, At, B0); PG8_MMA(0, 1, At, B1); PG8_BAR; PG8_SCHED;
            PG8_LDA(At, 1, 1); PG8_STAGE(PG8_SB(1, 0), b3, voffB); PG8_STAGE(PG8_SB(1, 1), b3 + hstep, voffB); PG8_STAGE(PG8_SA(1, 0), a3, voffA);
            PG8_WAIT_V(8); PG8_WAIT_L(0); PG8_BAR; PG8_MMA(1, 0, At, B0); PG8_MMA(1, 1, At, B1); PG8_BAR; PG8_SCHED;
            } else {
            PG8_LDB(B0, 0, 0); PG8_SCHED; PG8_LDA(At, 0, 0); PG8_STAGE(PG8_SA(1, 1), a1 + hstep, voffA);
            PG8_WAIT_L(8); PG8_BAR; PG8_WAIT_L(0); PG8_MMA(0, 0, At, B0); PG8_BAR; PG8_SCHED;
            PG8_LDB(B1, 0, 1); PG8_STAGE(PG8_SB(0, 0), b2, voffB);
            PG8_BAR; PG8_WAIT_L(0); PG8_MMA(0, 1, At, B1); PG8_BAR;
            PG8_LDA(At, 0, 1); PG8_STAGE(PG8_SA(0, 0), a2, voffA);
            PG8_BAR; PG8_WAIT_L(0); PG8_MMA(1, 0, At, B0); PG8_BAR; PG8_SCHED;
            PG8_STAGE(PG8_SB(0, 1), b2 + hstep, voffB);
            PG8_WAIT_V(6); PG8_BAR; PG8_MMA(1, 1, At, B1); PG8_BAR;
            PG8_LDB(B0, 1, 0); PG8_SCHED; PG8_LDA(At, 1, 0); PG8_STAGE(PG8_SA(0, 1), a2 + hstep, voffA);
            PG8_WAIT_L(8); PG8_BAR; PG8_WAIT_L(0); PG8_MMA(0, 0, At, B0); PG8_BAR; PG8_SCHED;
            PG8_LDB(B1, 1, 1); PG8_STAGE(PG8_SB(1, 0), b3, voffB);
            PG8_BAR; PG8_WAIT_L(0); PG8_MMA(0, 1, At, B1); PG8_BAR;
            PG8_LDA(At, 1, 1); PG8_STAGE(PG8_SA(1, 0), a3, voffA);
            PG8_BAR; PG8_WAIT_L(0); PG8_MMA(1, 0, At, B0); PG8_BAR; PG8_SCHED;
            PG8_STAGE(PG8_SB(1, 1), b3 + hstep, voffB);
            PG8_WAIT_V(6); PG8_BAR; PG8_MMA(1, 1, At, B1); PG8_BAR;
            }
        }
        if constexpr (ALIGN_EPI) { if (wr == 0) PG8_BAR; }
        if constexpr (!Epi::AFTER_DRAIN) { E(acc, cur, wr, wc, fr, fq); S.done(cur); }
        if (!has_next) break;
#pragma unroll
        for (int a = 0; a < 2; ++a)
#pragma unroll
            for (int b = 0; b < 2; ++b)
#pragma unroll
                for (int m = 0; m < 4; ++m)
#pragma unroll
                    for (int n = 0; n < 2; ++n) acc[a][b][m][n] = (f32x4){0.f, 0.f, 0.f, 0.f};
        cur = nxt; cA = nA; cB = nB; ++ui;
        if constexpr (ALIGN_EPI) { if (wr == 1) PG8_BAR; }
    }
    PG8_WAIT_V(0);
    if constexpr (!ALIGN_EPI) { if (wr == 0) PG8_BAR; }
    PG8_BAR;
    if constexpr (Epi::AFTER_DRAIN) { E.fused(acc, cur, wr, wc, fr, fq, lds, wid, lane); S.done(cur); }
#undef PG8_SA
#undef PG8_SB
#undef PG8_STAGE
#undef PG8_LDA
#undef PG8_LDB
#undef PG8_MMA
#undef PG8_WAIT_V
#undef PG8_WAIT_L
#undef PG8_BAR
#undef PG8_SCHED
}
}

#ifndef PG8_SP2
#define PG8_SP2 true
#endif
#ifndef PG8_ALIGN
#define PG8_ALIGN true
#endif
#include <hip/hip_bf16.h>
#include <cmath>
namespace attn_body {
using bf16=__hip_bfloat16;
using bf16x8=__attribute__((ext_vector_type(8)))short;
using s16x4=__attribute__((ext_vector_type(4)))short;
using f32x16=__attribute__((ext_vector_type(16)))float;
using u32x4=__attribute__((ext_vector_type(4)))unsigned;
constexpr int BATCH=8,NHEAD=16,SEQ=2048,D=64,DM=NHEAD*D;
constexpr int NW=8,QBLK=32,QB=QBLK*NW,KVBLK=64,NQB=SEQ/QB;
constexpr int ATTN_PITCH=DM, ATTN_UNIT_ROWS=QB;
__device__ __forceinline__ int crow(int r,int hi){return (r&3)+8*(r>>2)+4*hi;}
#define SBAR() __builtin_amdgcn_sched_barrier(0)
__device__ __forceinline__ void cmask(f32x16&p0,f32x16&p1,int jb,int qrel,int hi){
  const float NEG=-INFINITY; int kb=64*jb+4*hi;
  #pragma unroll
  for(int r=0;r<16;++r){int kv=kb+(r&3)+8*(r>>2); if(kv>qrel)p0[r]=NEG; if(kv+32>qrel)p1[r]=NEG;}
}

constexpr int NSLOT=3, SLOTB=8192;
constexpr int LDS_K=0, LDS_V=NSLOT*SLOTB, LDS_WS=2*NSLOT*SLOTB, LDS_OST=LDS_WS+NW*64*4, LDS_BYTES=LDS_OST+NW*4096;
constexpr float C2=0.125f*1.4426950408889634f;
__device__ __forceinline__ void glds16(const void*gsrc,unsigned lds_dst){unsigned keep;
  asm volatile("s_mov_b32 %0, m0\n\ts_mov_b32 m0, %2\n\ts_nop 0\n\tglobal_load_lds_dwordx4 %1, off\n\ts_mov_b32 m0, %0":"=&s"(keep):"v"(gsrc),"s"(lds_dst):"memory");}
__device__ __forceinline__ float max3f(float a,float b,float c){float r;asm("v_max3_f32 %0, %1, %2, %3":"=v"(r):"v"(a),"v"(b),"v"(c));return r;}
__device__ __forceinline__ float max2f(float a,float b){float r;asm("v_max_f32_e32 %0, %1, %2":"=v"(r):"v"(a),"v"(b));return r;}
__device__ __forceinline__ float fadd_s(float a,float b){float r;asm("v_add_f32_e32 %0, %1, %2":"=v"(r):"v"(a),"v"(b));return r;}
__device__ __forceinline__ float fsub_s(float a,float b){float r;asm("v_sub_f32_e32 %0, %1, %2":"=v"(r):"v"(a),"v"(b));return r;}
typedef float f32x2_t __attribute__((ext_vector_type(2))); typedef __bf16 bf16x2_t __attribute__((ext_vector_type(2)));
__device__ __forceinline__ unsigned cvtpk_s(float lo,float hi){f32x2_t v={lo,hi};bf16x2_t b=__builtin_convertvector(v,bf16x2_t);return __builtin_bit_cast(unsigned,b);}
#define WAIT_BAR(N) asm volatile("s_waitcnt vmcnt(" #N ") lgkmcnt(0)\n\ts_barrier":::"memory")

__device__ __forceinline__ void qkt(f32x16&p0,f32x16&p1,const char*Kslot,const bf16x8*qr,const f32x16&negm,int r32,int hi){
  const char*kb=Kslot+hi*1024+r32*16;
  #pragma unroll
  for(int d0=0;d0<4;++d0){
    const bf16x8 b0=*reinterpret_cast<const bf16x8*>(kb+d0*2048);
    const bf16x8 b1=*reinterpret_cast<const bf16x8*>(kb+d0*2048+512);
    if(d0==0){p0=__builtin_amdgcn_mfma_f32_32x32x16_bf16(b0,qr[0],negm,0,0,0);p1=__builtin_amdgcn_mfma_f32_32x32x16_bf16(b1,qr[0],negm,0,0,0);}
    else{p0=__builtin_amdgcn_mfma_f32_32x32x16_bf16(b0,qr[d0],p0,0,0,0);p1=__builtin_amdgcn_mfma_f32_32x32x16_bf16(b1,qr[d0],p1,0,0,0);}}
}
typedef __attribute__((address_space(3))) const char* lds_cptr;
typedef short v4i16_t __attribute__((ext_vector_type(4)));
__device__ __forceinline__ void kload8(bf16x8*kf,lds_cptr kp){
  kf[0]=*(const __attribute__((address_space(3))) bf16x8*)(kp);      kf[1]=*(const __attribute__((address_space(3))) bf16x8*)(kp+512);
  kf[2]=*(const __attribute__((address_space(3))) bf16x8*)(kp+2048); kf[3]=*(const __attribute__((address_space(3))) bf16x8*)(kp+2560);
  kf[4]=*(const __attribute__((address_space(3))) bf16x8*)(kp+4096); kf[5]=*(const __attribute__((address_space(3))) bf16x8*)(kp+4608);
  kf[6]=*(const __attribute__((address_space(3))) bf16x8*)(kp+6144); kf[7]=*(const __attribute__((address_space(3))) bf16x8*)(kp+6656);
}
__device__ __forceinline__ void kload2(bf16x8*kf,lds_cptr kp,int j){ kf[2*j]=*(const __attribute__((address_space(3))) bf16x8*)(kp+j*2048); kf[2*j+1]=*(const __attribute__((address_space(3))) bf16x8*)(kp+j*2048+512); }
__device__ __forceinline__ s16x4 vtr(lds_cptr p){ return __builtin_bit_cast(s16x4,__builtin_amdgcn_ds_read_tr16_b64_v4i16((__attribute__((address_space(3))) v4i16_t*)p)); }
__device__ __forceinline__ float rowmax(const f32x16&p0,const f32x16&p1){
  float a=max3f(p0[0],p0[1],p1[0]),b=max3f(p0[2],p0[3],p1[1]);a=max3f(a,p1[2],p1[3]);
  #pragma unroll
  for(int r=4;r<16;r+=4){a=max3f(a,p0[r],p0[r+1]);b=max3f(b,p0[r+2],p0[r+3]);a=max3f(a,p1[r],p1[r+1]);b=max3f(b,p1[r+2],p1[r+3]);}
  const float m=max2f(a,b);
  auto rr=__builtin_amdgcn_permlane32_swap(__float_as_uint(m),__float_as_uint(m),false,false);
  return max2f(__uint_as_float(rr[0]),__uint_as_float(rr[1]));
}
__device__ __forceinline__ void pv(f32x16*o,int vb,bf16x8 pa0,bf16x8 pa1,bf16x8 pa2,bf16x8 pa3){
  #pragma unroll
  for(int d0=0;d0<2;++d0){s16x4 lo[4],hi[4];
    #pragma unroll
    for(int ks=0;ks<4;++ks){
      asm volatile("ds_read_b64_tr_b16 %0,%1 offset:%c2":"=&v"(lo[ks]):"v"(vb),"i"(d0*4096+ks*1024):"memory");
      asm volatile("ds_read_b64_tr_b16 %0,%1 offset:%c2":"=&v"(hi[ks]):"v"(vb),"i"(d0*4096+ks*1024+512):"memory");}
    asm volatile("s_waitcnt lgkmcnt(0)":::"memory");SBAR();
    #define PK(k) (bf16x8){lo[k][0],lo[k][1],lo[k][2],lo[k][3],hi[k][0],hi[k][1],hi[k][2],hi[k][3]}
    o[d0]=__builtin_amdgcn_mfma_f32_32x32x16_bf16(pa0,PK(0),o[d0],0,0,0);
    o[d0]=__builtin_amdgcn_mfma_f32_32x32x16_bf16(pa1,PK(1),o[d0],0,0,0);
    o[d0]=__builtin_amdgcn_mfma_f32_32x32x16_bf16(pa2,PK(2),o[d0],0,0,0);
    o[d0]=__builtin_amdgcn_mfma_f32_32x32x16_bf16(pa3,PK(3),o[d0],0,0,0);
    #undef PK
  }
}

#ifndef ATTN_STORE16
#define ATTN_STORE16(p,v) (*(u32x4*)(p)=(v))
#endif
template<int THRL> __device__ __forceinline__ void attn_unit(int b,int h,int qb,int vcol,int ocol,const bf16*Q,const bf16*__restrict__ K,const bf16*__restrict__ V,bf16*O,char*shm){
  int tid_=threadIdx.x; asm volatile("":"+v"(tid_)); const int tid=tid_,lane=tid&63,r32=lane&31,hi=lane>>5; const int wid=__builtin_amdgcn_readfirstlane(tid>>6);
  const long rowbase=(long)b*SEQ; const int q0=qb*QB;
  const bf16*Qw=Q+(rowbase+q0+wid*QBLK)*DM+h*D;
  const bf16*Kh=K+rowbase*DM+h*D,*Vh=V+rowbase*DM+vcol;
  const unsigned lds0=(unsigned)(uintptr_t)shm;
  float*wsf=(float*)(shm+LDS_WS)+wid*64;
  const bf16*ksrc=Kh+(long)lane*DM+wid*8;
  const bf16*vsrc=Vh+(long)(16*(wid&3)+(lane>>2))*DM+(wid>>2)*32+(lane&3)*8;
  const unsigned kdst=lds0+LDS_K+wid*1024, vdst=lds0+LDS_V+wid*1024;
  #define DMA_K(t,slot) glds16(ksrc+(long)(t)*KVBLK*DM,(unsigned)__builtin_amdgcn_readfirstlane(kdst+(slot)))
  #define DMA_V(t,slot) glds16(vsrc+(long)(t)*KVBLK*DM,(unsigned)__builtin_amdgcn_readfirstlane(vdst+(slot)))
  const int vb0=(int)(lds0+LDS_V)+((lane>>4)&1)*32+(lane&3)*8+(4*hi+((lane&15)>>2))*64;
  const char*Kbase=shm+LDS_K; bf16x8 kf[8];
  const lds_cptr shm3=(lds_cptr)shm; const lds_cptr kp0=shm3+LDS_K+hi*1024+r32*16; const lds_cptr vp0=shm3+LDS_V+((lane>>4)&1)*32+(lane&3)*8+(4*hi+((lane&15)>>2))*64;
  const int NT=(q0+QB)/KVBLK;
  DMA_K(0,0);DMA_V(0,0);DMA_K(1,SLOTB);
  bf16x8 qr[4];
  #pragma unroll
  for(int d0=0;d0<4;++d0)qr[d0]=*reinterpret_cast<const bf16x8*>(&Qw[(long)r32*DM+d0*16+hi*8]);
  float mhat=0.f,l_reg=0.f;f32x16 o[2];o[0]=f32x16{};o[1]=f32x16{};f32x16 negm=f32x16{};asm volatile("":"+v"(negm));
  const int qrel=wid*QBLK+r32;
  #define CMASK(P0,P1,t) do{int jb_=(t)-(NT-4); if(jb_>=0)cmask(P0,P1,jb_,qrel,hi);}while(0)
  bool resc=false;
  #define START(P0,P1) do{ const float rm=rowmax(P0,P1); resc=false; \
    { const float dl=rm; mhat=fadd_s(mhat,dl); \
      _Pragma("unroll") for(int r=0;r<16;++r){P0[r]=fsub_s(P0[r],dl);P1[r]=fsub_s(P1[r],dl);} \
      _Pragma("unroll") for(int r=0;r<16;++r)negm[r]=-mhat; asm volatile("":"+v"(negm)); } \
    _Pragma("unroll") for(int r=0;r<16;++r)P0[r]=__builtin_amdgcn_exp2f(P0[r]); }while(0)
  #define RESC() do{ if(resc){ asm volatile("s_waitcnt lgkmcnt(0)":::"memory"); \
      _Pragma("unroll") for(int d_=0;d_<2;++d_) _Pragma("unroll") for(int r=0;r<16;++r)o[d_][r]*=wsf[crow(r,hi)]; } }while(0)
  f32x16 pA0,pA1,pB0,pB1;
  int sl_prev=0,sl_cur=0,sl_next=SLOTB;
  #define ROT() do{sl_prev=sl_cur;sl_cur=sl_next;sl_next=(sl_next==(NSLOT-1)*SLOTB)?0:sl_next+SLOTB;}while(0)
  DMA_K(2,2*SLOTB);
  WAIT_BAR(3);
  qkt(pA0,pA1,Kbase,qr,negm,r32,hi);asm volatile("s_nop 15\n\ts_nop 7":"+v"(pA0),"+v"(pA1));CMASK(pA0,pA1,0);
  START(pA0,pA1);
  _Pragma("unroll") for(int r=0;r<16;++r)pA1[r]=__builtin_amdgcn_exp2f(pA1[r]);
  WAIT_BAR(0);
  DMA_K(3,0);DMA_V(1,SLOTB);
  ROT();
  kload8(kf,kp0+sl_cur);
  WAIT_BAR(2);
  s16x4 vlo[8],vhi[8]; u32x4 pw0,pw1,pw2,pw3;
  #define PKW(P,B) cvtpk_s(P[B],P[B+1])
  #define PAF(k) __builtin_bit_cast(bf16x8,pw##k)
  #define VFR(i) (bf16x8){vlo[i][0],vlo[i][1],vlo[i][2],vlo[i][3],vhi[i][0],vhi[i][1],vhi[i][2],vhi[i][3]}
  #define PIN(x) asm volatile("":"+v"(x))
  #define MX3(a,b,c) __builtin_fmaxf(__builtin_fmaxf((a),(b)),(c))
  #define GAPA(MF,A0,A1,A2,A3,W0,W1,PW) do{ MF; sacc+=A0; sacc+=A1; sacc+=A2; sacc+=A3; PIN(sacc); W0; W1; PIN(PW); SBAR(); }while(0)
  #define EX(v) __builtin_amdgcn_exp2f(v)
  #define GAPB(MF,X,B) do{ MF; X[B]=EX(X[B]); X[B+1]=EX(X[B+1]); X[B+2]=EX(X[B+2]); X[B+3]=EX(X[B+3]); PIN(X); SBAR(); }while(0)
  #define VRD(i) do{ vlo[i]=vtr(vp_+(((i)>>2)*4096+((i)&3)*1024)); vhi[i]=vtr(vp_+(((i)>>2)*4096+((i)&3)*1024+512)); }while(0)
  #define KRD(G,j) do{ if(G){ kload2(kf,kp0+sl_next,j); SBAR(); } }while(0)
  #define STEP(C0,C1,P0,P1,t,GK,GV,GL) do{ SBAR(); \
    const lds_cptr vp_=vp0+sl_prev; \
    VRD(0); SBAR(); float sacc=(P0[0]+P0[1]); \
    GAPA(C0=__builtin_amdgcn_mfma_f32_32x32x16_bf16(kf[0],qr[0],negm,0,0,0), P0[2],P0[3],P0[4],P0[5],     pw0[0]=PKW(P0,0), pw0[1]=PKW(P0,2), pw0); \
    VRD(4); SBAR(); GAPA(C1=__builtin_amdgcn_mfma_f32_32x32x16_bf16(kf[1],qr[0],negm,0,0,0), P0[6],P0[7],P0[8],P0[9],     pw0[2]=PKW(P0,4), pw0[3]=PKW(P0,6), pw0); \
    VRD(1); SBAR(); GAPA(C0=__builtin_amdgcn_mfma_f32_32x32x16_bf16(kf[2],qr[1],C0,0,0,0),   P0[10],P0[11],P0[12],P0[13], pw1[0]=PKW(P0,8), pw1[1]=PKW(P0,10), pw1); \
    VRD(5); SBAR(); GAPA(C1=__builtin_amdgcn_mfma_f32_32x32x16_bf16(kf[3],qr[1],C1,0,0,0),   P0[14],P0[15],P1[0],P1[1],   pw1[2]=PKW(P0,12),pw1[3]=PKW(P0,14), pw1); \
    VRD(2); SBAR(); GAPA(C0=__builtin_amdgcn_mfma_f32_32x32x16_bf16(kf[4],qr[2],C0,0,0,0),   P1[2],P1[3],P1[4],P1[5],     pw2[0]=PKW(P1,0), pw2[1]=PKW(P1,2), pw2); \
    VRD(6); SBAR(); GAPA(C1=__builtin_amdgcn_mfma_f32_32x32x16_bf16(kf[5],qr[2],C1,0,0,0),   P1[6],P1[7],P1[8],P1[9],     pw2[2]=PKW(P1,4), pw2[3]=PKW(P1,6), pw2); \
    VRD(3); SBAR(); GAPA(C0=__builtin_amdgcn_mfma_f32_32x32x16_bf16(kf[6],qr[3],C0,0,0,0),   P1[10],P1[11],P1[12],P1[13], pw3[0]=PKW(P1,8), pw3[1]=PKW(P1,10), pw3); \
    VRD(7); SBAR(); GAPA(C1=__builtin_amdgcn_mfma_f32_32x32x16_bf16(kf[7],qr[3],C1,0,0,0),   P1[14],P1[15],0.f,0.f,       pw3[2]=PKW(P1,12),pw3[3]=PKW(P1,14), pw3); \
    l_reg+=sacc; \
    if(GK){DMA_K((t)+3,sl_cur);} if(GV){DMA_V((t)+1,sl_next);} \
    CMASK(C0,C1,t); \
    { float a=MX3(C0[0],C0[1],C1[0]),b=MX3(C0[2],C0[3],C1[1]); a=MX3(a,C1[2],C1[3]); \
      _Pragma("unroll") for(int r=4;r<16;r+=4){a=MX3(a,C0[r],C0[r+1]);b=MX3(b,C0[r+2],C0[r+3]);a=MX3(a,C1[r],C1[r+1]);b=MX3(b,C1[r+2],C1[r+3]);} \
      float rm=__builtin_fmaxf(a,b); { auto rr=__builtin_amdgcn_permlane32_swap(__float_as_uint(rm),__float_as_uint(rm),false,false); rm=__builtin_fmaxf(__uint_as_float(rr[0]),__uint_as_float(rr[1])); } \
      resc=false; \
      if(__builtin_expect(__any(rm>(float)THRL),0)){ const float dl=__builtin_fmaxf(rm,0.f); mhat+=dl; \
        _Pragma("unroll") for(int r=0;r<16;++r){C0[r]-=dl;C1[r]-=dl;} \
        _Pragma("unroll") for(int r=0;r<16;++r)negm[r]=-mhat; asm volatile("":"+v"(negm)); \
        const float f=__builtin_amdgcn_exp2f(-dl); l_reg*=f; if(hi==0)wsf[r32]=f; resc=true; } } \
    SBAR(); \
    GAPB(o[0]=__builtin_amdgcn_mfma_f32_32x32x16_bf16(PAF(0),VFR(0),o[0],0,0,0), C0,0); \
    GAPB(o[1]=__builtin_amdgcn_mfma_f32_32x32x16_bf16(PAF(0),VFR(4),o[1],0,0,0), C0,4); \
    KRD(GL,0); GAPB(o[0]=__builtin_amdgcn_mfma_f32_32x32x16_bf16(PAF(1),VFR(1),o[0],0,0,0), C0,8); \
    KRD(GL,1); GAPB(o[1]=__builtin_amdgcn_mfma_f32_32x32x16_bf16(PAF(1),VFR(5),o[1],0,0,0), C0,12); \
    KRD(GL,2); GAPB(o[0]=__builtin_amdgcn_mfma_f32_32x32x16_bf16(PAF(2),VFR(2),o[0],0,0,0), C1,0); \
    KRD(GL,3); GAPB(o[1]=__builtin_amdgcn_mfma_f32_32x32x16_bf16(PAF(2),VFR(6),o[1],0,0,0), C1,4); \
    GAPB(o[0]=__builtin_amdgcn_mfma_f32_32x32x16_bf16(PAF(3),VFR(3),o[0],0,0,0), C1,8); \
    GAPB(o[1]=__builtin_amdgcn_mfma_f32_32x32x16_bf16(PAF(3),VFR(7),o[1],0,0,0), C1,12); \
    }while(0)
  int t=1;
  #undef CMASK
  #define CMASK(P0,P1,t) do{}while(0)
  for(;t+5<NT;t+=2){
    STEP(pB0,pB1,pA0,pA1,t,true,true,true);     WAIT_BAR(2); RESC(); ROT();
    STEP(pA0,pA1,pB0,pB1,t+1,true,true,true);   WAIT_BAR(2); RESC(); ROT();
  }
  #undef CMASK
  #define CMASK(P0,P1,t) do{int jb_=(t)-(NT-4); if(jb_>=0)cmask(P0,P1,jb_,qrel,hi);}while(0)
  #define ENDW(tt) do{ if((tt)+3<NT){WAIT_BAR(2);} else if((tt)+2<NT){WAIT_BAR(1);} else {WAIT_BAR(0);} }while(0)
  for(;t+1<NT;t+=2){
    STEP(pB0,pB1,pA0,pA1,t,(t+3<NT),(t+1<NT),(t+1<NT));       ENDW(t);   RESC(); ROT();
    STEP(pA0,pA1,pB0,pB1,t+1,(t+4<NT),(t+2<NT),(t+2<NT));     ENDW(t+1); RESC(); ROT();
  }
  STEP(pB0,pB1,pA0,pA1,NT-1,false,false,false); RESC();
  { float sacc=pB0[0]+pB0[1]; _Pragma("unroll") for(int r=2;r<16;++r)sacc+=pB0[r]; _Pragma("unroll") for(int r=0;r<16;++r)sacc+=pB1[r]; l_reg+=sacc;
    pw0=(u32x4){PKW(pB0,0),PKW(pB0,2),PKW(pB0,4),PKW(pB0,6)};pw1=(u32x4){PKW(pB0,8),PKW(pB0,10),PKW(pB0,12),PKW(pB0,14)};pw2=(u32x4){PKW(pB1,0),PKW(pB1,2),PKW(pB1,4),PKW(pB1,6)};pw3=(u32x4){PKW(pB1,8),PKW(pB1,10),PKW(pB1,12),PKW(pB1,14)};
    SBAR(); pv(o,vb0+sl_cur,PAF(0),PAF(1),PAF(2),PAF(3)); }
  #undef PKW
  #undef PAF
  #undef VFR
  #undef PIN
  #undef MX3
  #undef GAPA
  #undef GAPB
  #undef EX
  #undef VRD
  #undef KRD
  #undef STEP
  #undef ENDW
  {auto rr=__builtin_amdgcn_permlane32_swap(__float_as_uint(l_reg),__float_as_uint(l_reg),false,false);l_reg=__uint_as_float(rr[0])+__uint_as_float(rr[1]);}
  if(hi==0)wsf[32+r32]=l_reg;asm volatile("s_waitcnt lgkmcnt(0)":::"memory");
  float rli[16];
  #pragma unroll
  for(int r=0;r<16;++r)rli[r]=__builtin_amdgcn_rcpf(wsf[32+crow(r,hi)]);
  bf16*Ow=O+(rowbase+q0+wid*QBLK)*DM+ocol;
  { bf16*stg=(bf16*)(shm+LDS_OST)+wid*2048;
    #pragma unroll
    for(int r=0;r<16;++r){const int orow=crow(r,hi);
      #pragma unroll
      for(int d0=0;d0<2;++d0)stg[orow*64+d0*32+r32]=__float2bfloat16(o[d0][r]*rli[r]);}
    asm volatile("s_waitcnt lgkmcnt(0)":::"memory");
    #pragma unroll
    for(int i=0;i<4;++i){const int row=i*8+(lane>>3),ch=lane&7; const u32x4 v=*(const u32x4*)(stg+row*64+ch*8); ATTN_STORE16(Ow+(long)row*DM+ch*8,v);} }
  asm volatile("s_waitcnt lgkmcnt(0)\n\ts_barrier":::"memory");
  #undef DMA_K
  #undef DMA_V
  #undef CMASK
  #undef START
  #undef RESC
  #undef ROT
}
constexpr int ATTN_LDS_BYTES=LDS_BYTES;
#undef SBAR
#undef WAIT_BAR
}

namespace cg = cooperative_groups;
#define LAS __attribute__((address_space(3)))
typedef unsigned short bf16;
typedef unsigned v4u __attribute__((ext_vector_type(4)));
typedef unsigned v2u __attribute__((ext_vector_type(2)));
typedef float f32x4 __attribute__((ext_vector_type(4)));
typedef short bf16x8 __attribute__((ext_vector_type(8)));

constexpr int NWAVES = 8, NTHR = 512;
constexpr int M = 16384, D = 1024, SEQL = 2048, NB = 8, FF = 2816;
constexpr int DIN = 9232;
constexpr float EPS = 1e-6f;
constexpr size_t MiB = 1u << 20;
constexpr size_t WS_G = 1 * MiB, WS_BETA = WS_G + 512 * 1024, WS_GL = 2 * MiB;
constexpr size_t WS_WING = 3 * MiB, WS_WINA = 11 * MiB, WS_WINX = 17 * MiB, WS_WBA = 21 * MiB, WS_WBB = 23 * MiB, WS_WOUT = 25 * MiB;
constexpr size_t WS_WUP = 27 * MiB, WS_WDN = 38 * MiB, WS_XN = 44 * MiB, WS_BIG = 76 * MiB;
constexpr size_t B_GQ = WS_BIG, B_GK = WS_BIG + 32 * MiB, B_GV = WS_BIG + 64 * MiB, B_GZ = WS_BIG + 96 * MiB, B_WB = WS_BIG + 128 * MiB, B_AQK = WS_BIG + 160 * MiB;
constexpr size_t B_Q = WS_BIG, B_K = WS_BIG + 32 * MiB, B_V = WS_BIG + 64 * MiB, B_O1 = WS_BIG + 96 * MiB, B_O2 = WS_BIG + 128 * MiB;
constexpr size_t B_GATES = WS_BIG + 32 * MiB, B_MRG = WS_BIG + 96 * MiB;
constexpr size_t B_U = WS_BIG, B_ACT = WS_BIG + 88 * MiB, B_F = WS_BIG;
constexpr int RING_BYTES = 131072, LDS_BYTES = 147456;

__device__ __forceinline__ unsigned f2bf(float f) { unsigned u = __builtin_bit_cast(unsigned, f); return (u + 0x7fffu + ((u >> 16) & 1u)) >> 16; }
typedef float f32x2_pk __attribute__((ext_vector_type(2))); typedef __bf16 bf16x2_pk __attribute__((ext_vector_type(2)));
__device__ __forceinline__ unsigned pk2(float lo, float hi) { f32x2_pk v = {lo, hi}; bf16x2_pk b = __builtin_convertvector(v, bf16x2_pk); return __builtin_bit_cast(unsigned, b); }
__device__ __forceinline__ float bflo(unsigned w) { return __builtin_bit_cast(float, w << 16); }
__device__ __forceinline__ float bfhi(unsigned w) { return __builtin_bit_cast(float, w & 0xffff0000u); }
__device__ __forceinline__ float bf1(bf16 h) { return __builtin_bit_cast(float, (unsigned)h << 16); }
__device__ __forceinline__ float sigmoidf_(float x) { return __builtin_amdgcn_rcpf(1.f + __expf(-x)); }
__device__ __forceinline__ float siluf_(float x) { return x * __builtin_amdgcn_rcpf(1.f + __expf(-x)); }
__device__ __forceinline__ float wave_sum(float v) {
#pragma unroll
    for (int o = 1; o < 64; o <<= 1) v += __shfl_xor(v, o);
    return v;
}
__device__ __forceinline__ void unpack8(const v4u w, float* f) { f[0] = bflo(w.x); f[1] = bfhi(w.x); f[2] = bflo(w.y); f[3] = bfhi(w.y); f[4] = bflo(w.z); f[5] = bfhi(w.z); f[6] = bflo(w.w); f[7] = bfhi(w.w); }

namespace pg8 {
template <bool ADD> struct EpiGate {
    static constexpr bool PERM = true, AFTER_DRAIN = false;
    bf16_t* O; const bf16_t* gates; int gofs;
    __device__ __forceinline__ void operator()(const f32x4 (&acc)[2][2][4][2], const Unit& u, int wr, int wc, int fr, int fq) const {
        const int row0 = u.pm * BM + wr * 64 + fr, col0 = u.pn * BM + wc * 32 + 8 * fq;
#pragma unroll
        for (int ai = 0; ai < 2; ++ai)
#pragma unroll
            for (int m = 0; m < 4; ++m) { const size_t row = (size_t)(row0 + ai * HALF + m * 16);
#pragma unroll
                for (int bj = 0; bj < 2; ++bj) { const int col = col0 + bj * HALF;
                    const u32x4 gw = *(const u32x4*)(gates + row * 2048 + gofs + col);
                    float g[8]; g[0] = __builtin_bit_cast(float, gw.x << 16); g[1] = __builtin_bit_cast(float, gw.x & 0xffff0000u); g[2] = __builtin_bit_cast(float, gw.y << 16); g[3] = __builtin_bit_cast(float, gw.y & 0xffff0000u);
                    g[4] = __builtin_bit_cast(float, gw.z << 16); g[5] = __builtin_bit_cast(float, gw.z & 0xffff0000u); g[6] = __builtin_bit_cast(float, gw.w << 16); g[7] = __builtin_bit_cast(float, gw.w & 0xffff0000u);
                    float v[8]; const f32x4 a0 = acc[ai][bj][m][0], a1 = acc[ai][bj][m][1];
                    v[0] = a0[0]; v[1] = a0[1]; v[2] = a0[2]; v[3] = a0[3]; v[4] = a1[0]; v[5] = a1[1]; v[6] = a1[2]; v[7] = a1[3];
#pragma unroll
                    for (int e = 0; e < 8; ++e) v[e] = v[e] * __builtin_amdgcn_rcpf(1.f + __expf(-g[e]));
                    bf16_t* op = O + row * 1024 + col;
                    if (ADD) { const u32x4 pw = *(const u32x4*)op;
                        v[0] += __builtin_bit_cast(float, pw.x << 16); v[1] += __builtin_bit_cast(float, pw.x & 0xffff0000u); v[2] += __builtin_bit_cast(float, pw.y << 16); v[3] += __builtin_bit_cast(float, pw.y & 0xffff0000u);
                        v[4] += __builtin_bit_cast(float, pw.z << 16); v[5] += __builtin_bit_cast(float, pw.z & 0xffff0000u); v[6] += __builtin_bit_cast(float, pw.w << 16); v[7] += __builtin_bit_cast(float, pw.w & 0xffff0000u); }
                    u32x4 w; w.x = cvt_pk_bf16(v[0], v[1]); w.y = cvt_pk_bf16(v[2], v[3]); w.z = cvt_pk_bf16(v[4], v[5]); w.w = cvt_pk_bf16(v[6], v[7]);
                    *(u32x4*)op = w; } }
    }
};
struct EpiF32 {
    static constexpr bool PERM = false, AFTER_DRAIN = false;
    float* O; int ldc;
    __device__ __forceinline__ void operator()(const f32x4 (&acc)[2][2][4][2], const Unit& u, int wr, int wc, int fr, int fq) const {
        const int row0 = u.pm * BM + wr * 64 + fr, col0 = u.pn * BM + wc * 32 + 4 * fq;
#pragma unroll
        for (int ai = 0; ai < 2; ++ai)
#pragma unroll
            for (int m = 0; m < 4; ++m) { float* rowp = O + (size_t)(row0 + ai * HALF + m * 16) * ldc + col0;
#pragma unroll
                for (int bj = 0; bj < 2; ++bj)
#pragma unroll
                    for (int n = 0; n < 2; ++n) *(f32x4*)(rowp + bj * HALF + n * 16) = acc[ai][bj][m][n]; }
    }
};

#define ROR1(v) __builtin_bit_cast(float, __builtin_amdgcn_update_dpp(0, __builtin_bit_cast(int, (v)), 0x121, 0xf, 0xf, false))
#define ROR2(v) __builtin_bit_cast(float, __builtin_amdgcn_update_dpp(0, __builtin_bit_cast(int, (v)), 0x122, 0xf, 0xf, false))
struct EpiConvAct {
    static constexpr bool PERM = true, AFTER_DRAIN = false;
    bf16_t* ACT; const float* cw; const float* cb; __attribute__((address_space(3))) unsigned char* xb;
    __device__ __forceinline__ void operator()(const f32x4 (&acc)[2][2][4][2], const Unit& u, int wr, int wc, int fr, int fq) const {
        typedef __attribute__((address_space(3))) f32x4 lf4;
        const int wave = wr * 4 + wc;
        lf4* XB = (lf4*)xb;
        if (fr >= 14) {
#pragma unroll
            for (int ai = 0; ai < 2; ++ai)
#pragma unroll
                for (int bj = 0; bj < 2; ++bj)
#pragma unroll
                    for (int n = 0; n < 2; ++n) XB[((((wave * 2 + ai) * 2 + (fr - 14)) * 4 + fq) * 2 + bj) * 2 + n] = acc[ai][bj][3][n];
        }
        asm volatile("s_waitcnt lgkmcnt(0)\n\ts_barrier" ::: "memory");
        const int f0 = u.pn * 128 + wc * 32 + 8 * fq;
        const int growb = u.pm * 254 - 2 + wr * 64 + fr;
        const int lane_ = fq * 16 + fr, src1_ = (lane_ & 48) | ((fr + 15) & 15), src2_ = (lane_ & 48) | ((fr + 14) & 15);
#pragma unroll
        for (int n = 0; n < 2; ++n) {
            const int fc = f0 + 4 * n;
            f32x4 wg[3], wu[3];
#pragma unroll
            for (int j = 0; j < 3; ++j) { wg[j] = *(const f32x4*)(cw + j * 5632 + fc); wu[j] = *(const f32x4*)(cw + j * 5632 + 2816 + fc); }
            const f32x4 bg = *(const f32x4*)(cb + fc), bu = *(const f32x4*)(cb + 2816 + fc);
#pragma unroll
            for (int ai = 0; ai < 2; ++ai) {
                f32x4 b14[2], b15[2];
                { int pw = wave, pa = ai; if (wr == 1) pw = wave - 4; else { pw = wave + 4; pa = 0; }
                  const bool has = (wr == 1) || (ai == 1);
#pragma unroll
                  for (int bj = 0; bj < 2; ++bj) { if (has) { b14[bj] = XB[((((pw * 2 + pa) * 2 + 0) * 4 + fq) * 2 + bj) * 2 + n]; b15[bj] = XB[((((pw * 2 + pa) * 2 + 1) * 4 + fq) * 2 + bj) * 2 + n]; }
                      else { b14[bj] = (f32x4){0.f, 0.f, 0.f, 0.f}; b15[bj] = b14[bj]; } } }
#pragma unroll
                for (int m = 0; m < 4; ++m) {
                    const int lr = ai * 128 + wr * 64 + m * 16 + fr; const int grow = growb + ai * 128 + m * 16; const int tt = grow & 2047;
                    const bool edge = __builtin_expect(__any(tt <= 1), 0);
                    float cvv[2][4];
#pragma unroll
                    for (int bj = 0; bj < 2; ++bj) {
                        const f32x4 xq = acc[ai][bj][m][n];
                        const float xs[4] = {xq.x, xq.y, xq.z, xq.w};
                        float ps[4] = {0.f, 0.f, 0.f, 0.f};
                        if (m > 0) { const f32x4 pq = acc[ai][bj][m > 0 ? m - 1 : 0][n]; ps[0] = pq.x; ps[1] = pq.y; ps[2] = pq.z; ps[3] = pq.w; }
                        const float b4[4] = {b14[bj].x, b14[bj].y, b14[bj].z, b14[bj].w}, b5[4] = {b15[bj].x, b15[bj].y, b15[bj].z, b15[bj].w};
                        const f32x4 W0 = bj ? wu[0] : wg[0], W1 = bj ? wu[1] : wg[1], W2 = bj ? wu[2] : wg[2], BB = bj ? bu : bg;
                        const float w0s[4] = {W0.x, W0.y, W0.z, W0.w}, w1s[4] = {W1.x, W1.y, W1.z, W1.w}, w2s[4] = {W2.x, W2.y, W2.z, W2.w}, bbs[4] = {BB.x, BB.y, BB.z, BB.w};
#pragma unroll
                        for (int e = 0; e < 4; ++e) {
                            float q1, q2;
                            if (m == 0) { q1 = b5[e]; q2 = (fr == 1) ? b5[e] : b4[e]; }
                            else { q1 = ROR1(ps[e]); q2 = ROR2(ps[e]); }
                            float a1 = __builtin_bit_cast(float, __builtin_amdgcn_update_dpp(__builtin_bit_cast(int, q1), __builtin_bit_cast(int, xs[e]), 0x111, 0xf, 0xf, false));
                            float a2 = __builtin_bit_cast(float, __builtin_amdgcn_update_dpp(__builtin_bit_cast(int, q2), __builtin_bit_cast(int, xs[e]), 0x112, 0xf, 0xf, false));
                            cvv[bj][e] = fmaf(w0s[e], a2, fmaf(w1s[e], a1, fmaf(w2s[e], xs[e], bbs[e])));
                            if (edge) { asm volatile("" ::: "memory");
                                if (tt == 0) cvv[bj][e] -= w1s[e] * a1; if (tt <= 1) cvv[bj][e] -= w0s[e] * a2; }
                        }
                    }
                    if (lr >= 2 && grow < 16384) {
                        float o[4];
#pragma unroll
                        for (int e = 0; e < 4; ++e) o[e] = cvv[0][e] * __builtin_amdgcn_rcpf(1.f + __expf(-cvv[0][e])) * cvv[1][e];
                        typedef unsigned u32x2 __attribute__((ext_vector_type(2)));
                        u32x2 w; w.x = cvt_pk_bf16(o[0], o[1]); w.y = cvt_pk_bf16(o[2], o[3]);
                        *(u32x2*)(ACT + (size_t)grow * 2816 + fc) = w;
                    }
                }
            }
        }
    }
};

struct EpiBf16Wait {
    static constexpr bool PERM = true, AFTER_DRAIN = false;
    EpiBf16<0> inner; const unsigned* prog;
    __device__ __forceinline__ void operator()(const f32x4 (&acc)[2][2][4][2], const Unit& u, int wr, int wc, int fr, int fq) const {
        const int b = u.pm >> 3; const unsigned need = 4u * (unsigned)(u.pm & 7) + 4u;
        for (int h = 0; h < 8; ++h) { unsigned spins = 0;
            while (__hip_atomic_load(prog + (b * 8 + h) * 16, __ATOMIC_RELAXED, __HIP_MEMORY_SCOPE_AGENT) < need) { __builtin_amdgcn_s_sleep(8); if (++spins > (1u << 22)) break; } }
        asm volatile("" ::: "memory");
        inner(acc, u, wr, wc, fr, fq);
    }
};
struct ChunkOrder {
    int G, c;
    __device__ __forceinline__ bool next(int i, Unit& u) const { const int L = i * G + c; if (L >= 512) return false; const int slot = L >> 6, within = L & 63; u.pm = (within >> 3) * 8 + slot; u.pn = within & 7; return true; }
    __device__ __forceinline__ void a_ready(const Unit&) const {}
    __device__ __forceinline__ void done(const Unit&) const {}
};
}

#define RLX_AGENT __ATOMIC_RELAXED, __HIP_MEMORY_SCOPE_AGENT
#define XB_TMO      128
#define XB_XCNT(j)  (256  + 64 * (j))
#define XB_XSUB(j)  (1280 + 64 * (j))
#define XB_XGEN(j)  (2304 + 64 * (j))
#define XB_TOP      3328
#define XB_TOPGEN   3392
#define XCD_BAR_WORDS 3456
#define XB_SPIN_CAP (1u << 18)

__device__ __forceinline__ unsigned xb_ld(unsigned* p)              { return __hip_atomic_load(p, __ATOMIC_RELAXED, __HIP_MEMORY_SCOPE_AGENT); }
__device__ __forceinline__ unsigned xb_add(unsigned* p, unsigned v) { return __hip_atomic_fetch_add(p, v, __ATOMIC_RELAXED, __HIP_MEMORY_SCOPE_AGENT); }
__device__ __forceinline__ unsigned xb_xcc_id() { return (unsigned)__builtin_amdgcn_s_getreg((3 << 11) | 20) & 0xFu; }
#define XB_SPIN(cond, bar) do { unsigned _sp = 0; while (cond) { __builtin_amdgcn_s_sleep(1); \
    if ((++_sp & 255u) == 0u) { if (xb_ld(&(bar)[XB_TMO])) break; if (_sp > XB_SPIN_CAP) { atomicAdd(&(bar)[XB_TMO], 1u); break; } } } } while (0)

struct XcdBarrier {
    unsigned* bar; unsigned x;
    volatile LAS unsigned* st;
};

__device__ __forceinline__ XcdBarrier xcd_barrier_post(unsigned* bar, volatile LAS unsigned* st) {
    XcdBarrier b; b.bar = bar; b.x = xb_xcc_id(); b.st = st;
    if (threadIdx.x == 0) (void)xb_add(&bar[XB_XCNT(b.x)], 1u);
    return b;
}
__device__ __forceinline__ void xcd_barrier_complete(unsigned* bar, unsigned x, unsigned& nloc, unsigned& nx) {
    const unsigned G = gridDim.x * gridDim.y * gridDim.z;
    unsigned sum, cnt, mine, sp = 0u;
    for (;;) {
        sum = 0u; cnt = 0u; mine = 0u;
#pragma unroll
        for (unsigned j = 0; j < 16; ++j) { const unsigned c = xb_ld(&bar[XB_XCNT(j)]); sum += c; cnt += (c > 0u) ? 1u : 0u; mine = (j == x) ? c : mine; }
        if (sum == G) break;
        __builtin_amdgcn_s_sleep(1);
        if ((++sp & 255u) == 0u) { if (xb_ld(&bar[XB_TMO])) break; if (sp > XB_SPIN_CAP) { atomicAdd(&bar[XB_TMO], 1u); break; } }
    }
    nloc = mine > 0u ? mine : 1u; nx = cnt > 0u ? cnt : 1u;
}

__device__ __forceinline__ void xcd_barrier(const XcdBarrier& b) {
    asm volatile("s_waitcnt vmcnt(0)" ::: "memory");
    __syncthreads();
    if (threadIdx.x == 0) {
        unsigned* bar = b.bar;
        __builtin_amdgcn_s_waitcnt(0);
        unsigned nloc = b.st[0], nx = b.st[1];
        if (nloc == 0u) { xcd_barrier_complete(bar, b.x, nloc, nx); b.st[0] = nloc; b.st[1] = nx; }
        const unsigned old = xb_add(&bar[XB_XSUB(b.x)], 1u);
        const unsigned gen = old / nloc;
        if (old + 1u == (gen + 1u) * nloc) {
            __builtin_amdgcn_fence(__ATOMIC_RELEASE, "agent");
            asm volatile("s_waitcnt vmcnt(0)" ::: "memory");
            const unsigned og = xb_add(&bar[XB_TOP], 1u);
            const unsigned tg = og / nx;
            if (og + 1u == (tg + 1u) * nx) xb_add(&bar[XB_TOPGEN], 1u);
            else XB_SPIN(xb_ld(&bar[XB_TOPGEN]) == tg, bar);
            __builtin_amdgcn_fence(__ATOMIC_ACQUIRE, "agent");
            xb_add(&bar[XB_XGEN(b.x)], 1u);
            asm volatile("s_waitcnt vmcnt(0)" ::: "memory");
        } else {
            XB_SPIN(xb_ld(&bar[XB_XGEN(b.x)]) == gen, bar);
            __builtin_amdgcn_fence(__ATOMIC_ACQUIRE, "agent");
            asm volatile("s_waitcnt vmcnt(0)" ::: "memory");
        }
    }
    __syncthreads();
}

struct Args { const float* in[22]; float* out; unsigned char* ws; int ph_lo, ph_hi; };

#define LDS_BAR() asm volatile("s_waitcnt lgkmcnt(0)\n\ts_barrier" ::: "memory")
struct Ctx {
    LAS unsigned char* lds; unsigned char* ws; int tid, lane, wave, G, bid;
};

__device__ __forceinline__ void transpose_item(const float* W, int ldw, int src_n0, int k0, int K, bf16* WT, int dst_n0, LAS float* scr, int lane) {
    float tv[32];
#pragma unroll
    for (int i = 0; i < 32; ++i) { const int kk = 2 * i + (lane >> 5); tv[i] = W[(size_t)(k0 + kk) * ldw + src_n0 + (lane & 31)]; }
#pragma unroll
    for (int i = 0; i < 32; ++i) { const int kk = 2 * i + (lane >> 5); scr[kk * 33 + (lane & 31)] = tv[i]; }
    asm volatile("s_waitcnt lgkmcnt(0)" ::: "memory");
    const int c = lane & 7;
#pragma unroll
    for (int j = 0; j < 4; ++j) { const int n = (lane >> 3) + 8 * j; const LAS float* s = scr + (8 * c) * 33 + n;
        v4u o; o.x = pk2(s[0 * 33], s[1 * 33]); o.y = pk2(s[2 * 33], s[3 * 33]); o.z = pk2(s[4 * 33], s[5 * 33]); o.w = pk2(s[6 * 33], s[7 * 33]);
        *(v4u*)(WT + (size_t)(dst_n0 + n) * K + k0 + 8 * c) = o; }
    asm volatile("s_waitcnt lgkmcnt(0)" ::: "memory");
}
__device__ __forceinline__ void p0_prologue(const Ctx& C, const Args& a) {
    unsigned char* ws = C.ws;
    LAS float* scr = (LAS float*)(C.lds + C.wave * 16384);
    const int gw = C.bid * NWAVES + C.wave, NGW = C.G * NWAVES;
    const float* w_in = a.in[2];
    constexpr int I_G = 16 * 128, I_A = 16 * 96;
    constexpr int NITEMS = I_G + I_A;
    for (int it = gw; it < NITEMS; it += NGW) {
        int r = it;
        if (r < I_G) { const int kb = r / 128, nb = r % 128; transpose_item(w_in, DIN, 32 * nb, 64 * kb, 1024, (bf16*)(ws + WS_WING), 32 * nb, scr, C.lane); continue; } r -= I_G;
        { const int kb = r / 96, nb = r % 96; transpose_item(w_in, DIN, 4112 + 32 * nb, 64 * kb, 1024, (bf16*)(ws + WS_WINA), 32 * nb, scr, C.lane); }
    }
    __syncthreads();
    LAS float* WabT = (LAS float*)C.lds;
    for (int k = C.tid; k < 1024; k += NTHR) {
        const f32x4* src = (const f32x4*)(w_in + (size_t)k * DIN + 4096);
#pragma unroll
        for (int q = 0; q < 4; ++q) { const f32x4 v = src[q]; WabT[(4 * q + 0) * 1024 + k] = v.x; WabT[(4 * q + 1) * 1024 + k] = v.y; WabT[(4 * q + 2) * 1024 + k] = v.z; WabT[(4 * q + 3) * 1024 + k] = v.w; }
    }
    __syncthreads();
    const float* x = a.in[0]; const float* gpre = a.in[1];
    bf16* XN = (bf16*)(ws + WS_XN); float* GA = (float*)(ws + WS_G); float* BE = (float*)(ws + WS_BETA);
    f32x4 gn[4];
#pragma unroll
    for (int j = 0; j < 4; ++j) gn[j] = ((const f32x4*)gpre)[C.lane + 64 * j];
    const int hsel = C.lane & 7;
    const float alog = a.in[4][hsel], dtb = a.in[5][hsel];
    for (int mp = gw; mp < M / 4; mp += NGW) {
        f32x4 v[4][4]; float ss[4] = {0.f, 0.f, 0.f, 0.f};
        { const f32x4* xr = (const f32x4*)(x + (size_t)(4 * mp) * D) + C.lane;
#pragma unroll
          for (int rr = 0; rr < 4; ++rr)
#pragma unroll
            for (int j = 0; j < 4; ++j) { v[rr][j] = xr[64 * j + 256 * rr]; ss[rr] += (v[rr][j].x * v[rr][j].x + v[rr][j].y * v[rr][j].y) + (v[rr][j].z * v[rr][j].z + v[rr][j].w * v[rr][j].w); } }
#pragma unroll
        for (int o = 1; o < 64; o <<= 1) {
#pragma unroll
            for (int rr = 0; rr < 4; ++rr) ss[rr] += __shfl_xor(ss[rr], o); }
        unsigned long long* o8 = (unsigned long long*)(XN + (size_t)(4 * mp) * D) + C.lane;
#pragma unroll
        for (int rr = 0; rr < 4; ++rr) { const float rs = __builtin_amdgcn_rsqf(ss[rr] * (1.f / D) + EPS);
#pragma unroll
            for (int j = 0; j < 4; ++j) { v[rr][j] = v[rr][j] * rs * gn[j]; o8[64 * j + 256 * rr] = (unsigned long long)pk2(v[rr][j].x, v[rr][j].y) | ((unsigned long long)pk2(v[rr][j].z, v[rr][j].w) << 32); } }
        float mine[4] = {0.f, 0.f, 0.f, 0.f};
#pragma unroll 2
        for (int c = 0; c < 16; ++c) { float pp[4] = {0.f, 0.f, 0.f, 0.f};
#pragma unroll
            for (int j = 0; j < 4; ++j) { const f32x4 w = *(const LAS f32x4*)(WabT + c * 1024 + 4 * C.lane + 256 * j);
#pragma unroll
                for (int rr = 0; rr < 4; ++rr) pp[rr] += (v[rr][j].x * w.x + v[rr][j].y * w.y) + (v[rr][j].z * w.z + v[rr][j].w * w.w); }
#pragma unroll
            for (int o = 1; o < 64; o <<= 1) {
#pragma unroll
                for (int rr = 0; rr < 4; ++rr) pp[rr] += __shfl_xor(pp[rr], o); }
#pragma unroll
            for (int rr = 0; rr < 4; ++rr) mine[rr] = (C.lane == c) ? pp[rr] : mine[rr]; }
#pragma unroll
        for (int rr = 0; rr < 4; ++rr) { const size_t m = (size_t)(4 * mp + rr);
            if (C.lane < 8) { const float z = mine[rr] + dtb; const float sp = fmaxf(z, 0.f) + log1pf(__expf(-fabsf(z))); GA[m * 8 + C.lane] = -__expf(alog) * sp; }
            else if (C.lane < 16) BE[m * 8 + (C.lane - 8)] = 1.f / (1.f + __expf(-mine[rr])); }
    }
}

__device__ __forceinline__ void late_transposes(const Ctx& C, const Args& a, int idx, int cnt) {
    unsigned char* ws = C.ws;
    LAS float* scr = (LAS float*)(C.lds + C.wave * 16384);
    const int gw = idx * NWAVES + C.wave, NGW = cnt * NWAVES;
    const float* w_in = a.in[2];
    constexpr int I_X = 16 * 64, I_S = 16 * 32, I_UP = 16 * 176, I_DN = 44 * 32;
    constexpr int NITEMS = I_X + 3 * I_S + I_UP + I_DN;
    for (int it = gw; it < NITEMS; it += NGW) {
        int r = it;
        if (r < I_X) { const int kb = r / 64, nb = r % 64; transpose_item(w_in, DIN, 7184 + 32 * nb, 64 * kb, 1024, (bf16*)(ws + WS_WINX), 32 * nb, scr, C.lane); continue; } r -= I_X;
        if (r < I_S) { const int kb = r / 32, nb = r % 32; transpose_item(a.in[12], 1024, 32 * nb, 64 * kb, 1024, (bf16*)(ws + WS_WBA), 32 * nb, scr, C.lane); continue; } r -= I_S;
        if (r < I_S) { const int kb = r / 32, nb = r % 32; transpose_item(a.in[13], 1024, 32 * nb, 64 * kb, 1024, (bf16*)(ws + WS_WBB), 32 * nb, scr, C.lane); continue; } r -= I_S;
        if (r < I_S) { const int kb = r / 32, nb = r % 32; transpose_item(a.in[14], 1024, 32 * nb, 64 * kb, 1024, (bf16*)(ws + WS_WOUT), 32 * nb, scr, C.lane); continue; } r -= I_S;
        if (r < I_UP) { const int kb = r / 176, nb = r % 176; const int dn0 = 32 * nb, tile = dn0 >> 8, within = dn0 & 255;
            const int src = within < 128 ? tile * 128 + within : FF + tile * 128 + (within - 128);
            transpose_item(a.in[17], 2 * FF, src, 64 * kb, 1024, (bf16*)(ws + WS_WUP), dn0, scr, C.lane); continue; } r -= I_UP;
        { const int kb = r / 32, nb = r % 32; transpose_item(a.in[20], 1024, 32 * nb, 64 * kb, FF, (bf16*)(ws + WS_WDN), 32 * nb, scr, C.lane); }
    }
    __syncthreads();
}

constexpr int GL_KN = 0, GL_QN = 17408, GL_KD = 34816, GL_RHS = 52224  , GL_AF = 118784  , GL_AQ = 136192  ;
constexpr int GL_TI = GL_KN  , GL_GC = 145408  ;
constexpr int GL_HALO = 145920  , GL_SEGH = 150528  ;
constexpr int LDS_TOTAL = 160 * 1024;
constexpr int GL_AFT = 152832;
static_assert(GL_SEGH + 9216 <= LDS_TOTAL, "lds");

__device__ __forceinline__ void gdn_halo_preload(const Ctx& C) {
    const bf16* GQ = (const bf16*)(C.ws + B_GQ);
    int s = 0;
    for (int seg = C.bid; seg < 256; seg += C.G, ++s) {
        const int b = seg >> 5, h = (seg >> 2) & 7, qt = seg & 3, c0 = qt * 8;
        LAS v4u* dst = (LAS v4u*)(C.lds + GL_SEGH + s * 2304);
        if (C.tid < 144) {
            const int rr = C.tid / 48, rem = C.tid % 48, X = rem / 16, ch = rem % 16;
            v4u v = {0u, 0u, 0u, 0u};
            if (c0 > 0) v = *(const v4u*)(GQ + (size_t)X * (16 * MiB) + (size_t)(b * SEQL + c0 * 64 - 3 + rr) * 1024 + h * 128 + ch * 8);
            dst[rr * 48 + X * 16 + ch] = v;
        }
    }
}

__device__ __forceinline__ void gdn_local_task(const Ctx& C, const Args& a, int b, int h, int c, const LAS unsigned char* halo_in, LAS unsigned char* halo_out, bool dry) {
    int tid_ = C.tid; asm volatile("" : "+v"(tid_)); const int tid = tid_, lane = tid & 63, wave = C.wave;
    const int r = tid >> 3, cgp = tid & 7;
    const size_t row0 = (size_t)b * SEQL + (size_t)c * 64;
    bf16* GQ = (bf16*)(C.ws + B_GQ); bf16* GK = (bf16*)(C.ws + B_GK); bf16* GV = (bf16*)(C.ws + B_GV);
    bf16* WB = (bf16*)(C.ws + B_WB); bf16* AQK = (bf16*)(C.ws + B_AQK);
    const float* GA = (const float*)(C.ws + WS_G); const float* BE = (const float*)(C.ws + WS_BETA); float* GLs = (float*)(C.ws + WS_GL);
    const float* convw = a.in[3];
    LAS unsigned char* lds = C.lds;
    float gcv, bev;
    { float g = GA[(row0 + lane) * 8 + h]; bev = BE[(row0 + lane) * 8 + h];
#pragma unroll
      for (int o = 1; o < 64; o <<= 1) { const float t = __shfl_up(g, o); if (lane >= o) g += t; }
      gcv = g; }
    const float gc_r = __shfl(gcv, r), be_r = __shfl(bev, r), gl = __shfl(gcv, 63);
    if (wave == 0) { ((LAS float*)(lds + GL_GC))[lane] = gcv; ((LAS float*)(lds + GL_GC))[64 + lane] = bev; if (lane == 63 && !dry) GLs[(b * 8 + h) * 32 + c] = __expf(gcv); }
    float y[3][16];
#pragma unroll
    for (int X = 0; X < 3; ++X) {
        const bf16* src = GQ + (size_t)X * (16 * MiB);
        v4u raw[4][2];
#pragma unroll
        for (int jj = 0; jj < 4; ++jj) { const int rr = r - 3 + jj;
            if (rr >= 0) { const v4u* p = (const v4u*)(src + (row0 + rr) * 1024 + h * 128 + cgp * 16); raw[jj][0] = p[0]; raw[jj][1] = p[1]; }
            else { const LAS v4u* p = (const LAS v4u*)(halo_in) + (3 + rr) * 48 + X * 16 + cgp * 2; raw[jj][0] = p[0]; raw[jj][1] = p[1]; } }
        if (r >= 61) { LAS v4u* p = (LAS v4u*)(halo_out) + (r - 61) * 48 + X * 16 + cgp * 2; p[0] = raw[3][0]; p[1] = raw[3][1]; }
        const float* wp = convw + X * 1024 + h * 128 + cgp * 16;
#pragma unroll
        for (int e = 0; e < 16; ++e) y[X][e] = 0.f;
#pragma unroll
        for (int jj = 0; jj < 4; ++jj) { float f[16]; unpack8(raw[jj][0], f); unpack8(raw[jj][1], f + 8);
#pragma unroll
            for (int q4 = 0; q4 < 4; ++q4) { const f32x4 w = *(const f32x4*)(wp + jj * 3072 + q4 * 4);
                y[X][4 * q4 + 0] += w.x * f[4 * q4 + 0]; y[X][4 * q4 + 1] += w.y * f[4 * q4 + 1]; y[X][4 * q4 + 2] += w.z * f[4 * q4 + 2]; y[X][4 * q4 + 3] += w.w * f[4 * q4 + 3]; } }
#pragma unroll
        for (int e = 0; e < 16; ++e) y[X][e] = siluf_(y[X][e]);
        if (X < 2) { float ss = 0.f;
#pragma unroll
            for (int e = 0; e < 16; ++e) ss += y[X][e] * y[X][e];
            ss += __shfl_xor(ss, 1); ss += __shfl_xor(ss, 2); ss += __shfl_xor(ss, 4);
            const float sc = (1.f / sqrtf(ss + EPS)) * (X == 0 ? 0.08838834764831845f : 1.f);
#pragma unroll
            for (int e = 0; e < 16; ++e) y[X][e] *= sc; }
    }
    const float eg = __expf(gc_r), ekd = __expf(gl - gc_r);
    { LAS unsigned* kn = (LAS unsigned*)(lds + GL_KN + r * 272 + cgp * 32); LAS unsigned* qn = (LAS unsigned*)(lds + GL_QN + r * 272 + cgp * 32); LAS unsigned* kd = (LAS unsigned*)(lds + GL_KD + r * 272 + cgp * 32);
      LAS float* rk = (LAS float*)(lds + GL_RHS) + r * 260 + cgp * 16; LAS float* rv = rk + 128;
#pragma unroll
      for (int e = 0; e < 8; ++e) { qn[e] = pk2(y[0][2 * e], y[0][2 * e + 1]); kn[e] = pk2(y[1][2 * e], y[1][2 * e + 1]); kd[e] = pk2(y[1][2 * e] * ekd, y[1][2 * e + 1] * ekd); }
      const float kb = be_r * eg;
#pragma unroll
      for (int e = 0; e < 16; ++e) { rk[e] = y[1][e] * kb; rv[e] = y[2][e] * be_r; } }
    LDS_BAR();
    {
      v4u o0, o1; o0.x = pk2(y[0][0] * eg, y[0][1] * eg); o0.y = pk2(y[0][2] * eg, y[0][3] * eg); o0.z = pk2(y[0][4] * eg, y[0][5] * eg); o0.w = pk2(y[0][6] * eg, y[0][7] * eg);
      o1.x = pk2(y[0][8] * eg, y[0][9] * eg); o1.y = pk2(y[0][10] * eg, y[0][11] * eg); o1.z = pk2(y[0][12] * eg, y[0][13] * eg); o1.w = pk2(y[0][14] * eg, y[0][15] * eg);
      v4u* p = (v4u*)(GQ + (row0 + r) * 1024 + h * 128 + cgp * 16); if (!dry) { p[0] = o0; p[1] = o1; } }
    const int fr = lane & 15, fq = lane >> 4;
    { const int ti = wave >> 1;
      const LAS float* gcs = (const LAS float*)(lds + GL_GC);
#pragma unroll
      for (int t2 = 0; t2 < 2; ++t2) { const int tj = (wave & 1) * 2 + t2;
          f32x4 kk = {0.f, 0.f, 0.f, 0.f}, qk = {0.f, 0.f, 0.f, 0.f};
          if (tj <= ti) {
#pragma unroll
              for (int ks = 0; ks < 4; ++ks) {
                  const bf16x8 ak = *(const LAS bf16x8*)(lds + GL_KN + (ti * 16 + fr) * 272 + ks * 64 + fq * 16);
                  const bf16x8 aq = *(const LAS bf16x8*)(lds + GL_QN + (ti * 16 + fr) * 272 + ks * 64 + fq * 16);
                  const bf16x8 bk = *(const LAS bf16x8*)(lds + GL_KN + (tj * 16 + fr) * 272 + ks * 64 + fq * 16);
                  kk = __builtin_amdgcn_mfma_f32_16x16x32_bf16(ak, bk, kk, 0, 0, 0);
                  qk = __builtin_amdgcn_mfma_f32_16x16x32_bf16(aq, bk, qk, 0, 0, 0);
              }
          }
          const int j = tj * 16 + fr; const float gcj = gcs[j];
#pragma unroll
          for (int rg = 0; rg < 4; ++rg) { const int i = ti * 16 + 4 * fq + rg; const float gci = gcs[i], bi = gcs[64 + i];
              const float dec = (i >= j) ? __expf(gci - gcj) : 0.f;
              const float av = (i > j) ? bi * dec * kk[rg] : 0.f;
              ((LAS float*)(lds + GL_AF))[i * 68 + j] = av;
              if (ti == tj) ((LAS float*)(lds + GL_AFT))[(ti * 16 + fr) * 20 + 4 * fq + rg] = av;
              ((LAS bf16*)(lds + GL_AQ))[i * 72 + j] = (bf16)f2bf((i >= j) ? dec * qk[rg] : 0.f); }
      } }
    LDS_BAR();
    if (wave < 4) { const int I = wave, rr = lane & 15; const LAS float* At = (const LAS float*)(lds + GL_AFT) + (16 * I) * 20;
        float t[16];
#pragma unroll
        for (int cc = 15; cc >= 0; --cc) { float s = 0.f; float acol[16];
#pragma unroll
            for (int q4 = 0; q4 < 4; ++q4) { const f32x4 v = *(const LAS f32x4*)(At + cc * 20 + 4 * q4); acol[4 * q4] = v.x; acol[4 * q4 + 1] = v.y; acol[4 * q4 + 2] = v.z; acol[4 * q4 + 3] = v.w; }
#pragma unroll
            for (int k = cc + 1; k < 16; ++k) s += t[k] * acol[k];
            t[cc] = (cc == rr) ? 1.f : ((cc < rr) ? -s : 0.f); }
        if (lane < 16) { LAS float* To = (LAS float*)(lds + GL_TI) + (I * 16 + rr) * 20;
#pragma unroll
            for (int q4 = 0; q4 < 4; ++q4) *(LAS f32x4*)(To + 4 * q4) = (f32x4){t[4 * q4], t[4 * q4 + 1], t[4 * q4 + 2], t[4 * q4 + 3]}; } }
    LDS_BAR();
    {
        f32x4 tinv[4];
#pragma unroll
        for (int I = 0; I < 4; ++I) tinv[I] = *(const LAS f32x4*)((const LAS float*)(lds + GL_TI) + (I * 16 + fr) * 20 + 4 * fq);
        LAS float* R0 = (LAS float*)(lds + GL_RHS) + (wave * 2) * 16 + fr; LAS float* R1 = R0 + 16;
        f32x4 Xa[4], Xb[4];
#pragma unroll
        for (int I = 0; I < 4; ++I) { f32x4 acca, accb;
#pragma unroll
            for (int rg = 0; rg < 4; ++rg) { acca[rg] = R0[(16 * I + 4 * fq + rg) * 260]; accb[rg] = R1[(16 * I + 4 * fq + rg) * 260]; }
#pragma unroll
            for (int J = 0; J < 4; ++J) if (J < I) { const f32x4 af = *(const LAS f32x4*)((const LAS float*)(lds + GL_AF) + (16 * I + fr) * 68 + 16 * J + 4 * fq);
#pragma unroll
                for (int s = 0; s < 4; ++s) { acca = __builtin_amdgcn_mfma_f32_16x16x4f32(-af[s], Xa[J][s], acca, 0, 0, 0); accb = __builtin_amdgcn_mfma_f32_16x16x4f32(-af[s], Xb[J][s], accb, 0, 0, 0); } }
            f32x4 xa = {0.f, 0.f, 0.f, 0.f}, xb = {0.f, 0.f, 0.f, 0.f};
#pragma unroll
            for (int s = 0; s < 4; ++s) { xa = __builtin_amdgcn_mfma_f32_16x16x4f32(tinv[I][s], acca[s], xa, 0, 0, 0); xb = __builtin_amdgcn_mfma_f32_16x16x4f32(tinv[I][s], accb[s], xb, 0, 0, 0); }
            Xa[I] = xa; Xb[I] = xb; }
#pragma unroll
        for (int I = 0; I < 4; ++I)
#pragma unroll
            for (int rg = 0; rg < 4; ++rg) { R0[(16 * I + 4 * fq + rg) * 260] = Xa[I][rg]; R1[(16 * I + 4 * fq + rg) * 260] = Xb[I][rg]; }
    }
    LDS_BAR();
    { const LAS float* X = (const LAS float*)(lds + GL_RHS) + r * 260 + cgp * 16;
      v4u o0, o1; o0.x = pk2(X[0], X[1]); o0.y = pk2(X[2], X[3]); o0.z = pk2(X[4], X[5]); o0.w = pk2(X[6], X[7]); o1.x = pk2(X[8], X[9]); o1.y = pk2(X[10], X[11]); o1.z = pk2(X[12], X[13]); o1.w = pk2(X[14], X[15]);
      v4u* p = (v4u*)(WB + (row0 + r) * 1024 + h * 128 + cgp * 16); if (!dry) { p[0] = o0; p[1] = o1; } }
    { const int e = tid & 127, jg = tid >> 7;
      const LAS float* Xu = (const LAS float*)(lds + GL_RHS) + (jg * 16) * 260 + 128 + e;
      const LAS bf16* Kd = (const LAS bf16*)(lds + GL_KD) + (jg * 16) * 136 + e;
      unsigned uo[8], ko[8];
#pragma unroll
      for (int jj = 0; jj < 8; ++jj) { uo[jj] = pk2(Xu[(2 * jj) * 260], Xu[(2 * jj + 1) * 260]); ko[jj] = (unsigned)Kd[(2 * jj) * 136] | ((unsigned)Kd[(2 * jj + 1) * 136] << 16); }
      const size_t off = (row0 + (e >> 1)) * 1024 + h * 128 + (e & 1) * 64 + jg * 16;
      if (!dry) { v4u* pu = (v4u*)(GV + off); pu[0] = (v4u){uo[0], uo[1], uo[2], uo[3]}; pu[1] = (v4u){uo[4], uo[5], uo[6], uo[7]};
      v4u* pk = (v4u*)(GK + off); pk[0] = (v4u){ko[0], ko[1], ko[2], ko[3]}; pk[1] = (v4u){ko[4], ko[5], ko[6], ko[7]}; } }
    { const v4u v = *(const LAS v4u*)(lds + GL_AQ + r * 144 + cgp * 16); if (!dry) *(v4u*)(AQK + (row0 + r) * 512 + h * 64 + cgp * 8) = v; }
    LDS_BAR();
}

__device__ __forceinline__ void gdn_local_phase(const Ctx& C, const Args& a, bool dry) {
    int s = 0;
    for (int seg = C.bid; seg < 256; seg += C.G, ++s) {
        const int b = seg >> 5, h = (seg >> 2) & 7, qt = seg & 3, c0 = qt * 8;
        for (int c = c0; c < c0 + 8; ++c) {
            const LAS unsigned char* hin = (c == c0) ? (C.lds + GL_SEGH + s * 2304) : (C.lds + GL_HALO + (c & 1) * 2304);
            LAS unsigned char* hout = C.lds + GL_HALO + ((c + 1) & 1) * 2304;
            gdn_local_task(C, a, b, h, c, hin, hout, dry);
        }
    }
}

constexpr int GS_ST = 0  , GS_VN = 34816  , GS_OS = 53248  ;
__device__ __forceinline__ void gdn_scan_phase(const Ctx& C, const Args& a, int bh0, int bhstride) {
    int tid_ = C.tid; asm volatile("" : "+v"(tid_)); const int tid = tid_, lane = tid & 63, wave = C.wave, fr = lane & 15, fq = lane >> 4;
    const bf16* GQ = (const bf16*)(C.ws + B_GQ); const bf16* GK = (const bf16*)(C.ws + B_GK); const bf16* GV = (const bf16*)(C.ws + B_GV); const bf16* GZ = (const bf16*)(C.ws + B_GZ);
    const bf16* WB = (const bf16*)(C.ws + B_WB); const bf16* AQK = (const bf16*)(C.ws + B_AQK); const float* GLs = (const float*)(C.ws + WS_GL);
    bf16* OG = (bf16*)a.out;
    unsigned* prog = (unsigned*)(C.ws + 16384);
    LAS unsigned char* lds = C.lds;
    const int rt = wave >> 1, chh = wave & 1;
    const int r = tid >> 3, cgp = tid & 7;
    f32x4 gno[4];
#pragma unroll
    for (int q4 = 0; q4 < 4; ++q4) gno[q4] = *(const f32x4*)(a.in[6] + cgp * 16 + q4 * 4);
    for (int bh = bh0; bh < 64; bh += bhstride) {
        const int b = bh >> 3, h = bh & 7;
        f32x4 S[8];
#pragma unroll
        for (int t = 0; t < 8; ++t) S[t] = (f32x4){0.f, 0.f, 0.f, 0.f};
        for (int i = tid; i < 34816 / 4; i += NTHR) ((LAS unsigned*)(lds + GS_ST))[i] = 0u;
        __syncthreads();
        bf16x8 wA[4], qA[4], aq[2], kdA[2]; v2u uraw[4]; v4u zc[2]; float glc;
#define SCAN_LD_WQ(cc) do { const size_t row0n = (size_t)b * SEQL + (size_t)(cc) * 64; const size_t o = (row0n + rt * 16 + fr) * 1024 + h * 128 + fq * 8; \
            _Pragma("unroll") for (int ks = 0; ks < 4; ++ks) { wA[ks] = *(const bf16x8*)(WB + o + ks * 32); qA[ks] = *(const bf16x8*)(GQ + o + ks * 32); } } while (0)
#define SCAN_LD_U(cc) do { const size_t row0n = (size_t)b * SEQL + (size_t)(cc) * 64; \
            _Pragma("unroll") for (int t = 0; t < 4; ++t) { const int e = (chh * 4 + t) * 16 + fr; uraw[t] = *(const v2u*)(GV + (row0n + (e >> 1)) * 1024 + h * 128 + (e & 1) * 64 + rt * 16 + 4 * fq); } } while (0)
#define SCAN_LD_AK(cc) do { const size_t row0n = (size_t)b * SEQL + (size_t)(cc) * 64; \
            const size_t oa = (row0n + rt * 16 + fr) * 512 + h * 64 + fq * 8; aq[0] = *(const bf16x8*)(AQK + oa); aq[1] = *(const bf16x8*)(AQK + oa + 32); \
            const int d = wave * 16 + fr; const size_t ok = (row0n + (d >> 1)) * 1024 + h * 128 + (d & 1) * 64 + fq * 8; kdA[0] = *(const bf16x8*)(GK + ok); kdA[1] = *(const bf16x8*)(GK + ok + 32); \
            glc = GLs[bh * 32 + (cc)]; } while (0)
#define SCAN_LD_Z(cc) do { const size_t row0n = (size_t)b * SEQL + (size_t)(cc) * 64; const size_t oz = (row0n + r) * 1024 + h * 128 + cgp * 16; zc[0] = *(const v4u*)(GZ + oz); zc[1] = *(const v4u*)(GZ + oz + 8); } while (0)
        SCAN_LD_WQ(0); SCAN_LD_U(0); SCAN_LD_AK(0); SCAN_LD_Z(0);
        for (int c = 0; c < 32; ++c) {
            const size_t row0 = (size_t)b * SEQL + (size_t)c * 64;
            const int cn = (c + 1 < 32) ? c + 1 : c;
            f32x4 QS[4];
#pragma unroll
            for (int hb = 0; hb < 2; ++hb) { bf16x8 bs[2][4];
#pragma unroll
              for (int t2 = 0; t2 < 2; ++t2)
#pragma unroll
                  for (int ks = 0; ks < 4; ++ks) bs[t2][ks] = *(const LAS bf16x8*)(lds + GS_ST + ((chh * 4 + hb * 2 + t2) * 16 + fr) * 272 + ks * 64 + fq * 16);
              asm volatile("s_waitcnt lgkmcnt(0)" ::: "memory");
#pragma unroll
              for (int t2 = 0; t2 < 2; ++t2) { const int t = hb * 2 + t2; f32x4 WS = (f32x4){0.f, 0.f, 0.f, 0.f}; QS[t] = (f32x4){0.f, 0.f, 0.f, 0.f};
                  const int ct = chh * 4 + t;
#pragma unroll
                  for (int ks = 0; ks < 4; ++ks) {
                      WS = __builtin_amdgcn_mfma_f32_16x16x32_bf16(wA[ks], bs[t2][ks], WS, 0, 0, 0);
                      QS[t] = __builtin_amdgcn_mfma_f32_16x16x32_bf16(qA[ks], bs[t2][ks], QS[t], 0, 0, 0); }
                  const float v0 = bflo(uraw[t].x) - WS[0], v1 = bfhi(uraw[t].x) - WS[1], v2 = bflo(uraw[t].y) - WS[2], v3 = bfhi(uraw[t].y) - WS[3];
                  *(LAS v2u*)(lds + GS_VN + (ct * 16 + fr) * 144 + (rt * 16 + 4 * fq) * 2) = (v2u){pk2(v0, v1), pk2(v2, v3)}; } }
            SCAN_LD_WQ(cn); SCAN_LD_U(cn);
            LDS_BAR();
#pragma unroll
            for (int hb = 0; hb < 2; ++hb) { bf16x8 bv[4][2];
#pragma unroll
              for (int t4 = 0; t4 < 4; ++t4)
#pragma unroll
                  for (int ks = 0; ks < 2; ++ks) bv[t4][ks] = *(const LAS bf16x8*)(lds + GS_VN + ((((chh + hb) & 1) * 4 + t4) * 16 + fr) * 144 + ks * 64 + fq * 16);
              asm volatile("s_waitcnt lgkmcnt(0)" ::: "memory");
              if (hb == 0) {
#pragma unroll
                  for (int t = 0; t < 4; ++t) { const int ct = chh * 4 + t;
#pragma unroll
                      for (int ks = 0; ks < 2; ++ks) QS[t] = __builtin_amdgcn_mfma_f32_16x16x32_bf16(aq[ks], bv[t][ks], QS[t], 0, 0, 0);
#pragma unroll
                      for (int rg = 0; rg < 4; ++rg) ((LAS float*)(lds + GS_OS))[(rt * 16 + 4 * fq + rg) * 132 + ct * 16 + fr] = QS[t][rg]; } }
#pragma unroll
              for (int t4 = 0; t4 < 4; ++t4) { const int t = hb * 4 + t4; const int et = ((chh + hb) & 1) * 4 + t4; S[t] = S[t] * glc;
#pragma unroll
                  for (int ks = 0; ks < 2; ++ks) S[t] = __builtin_amdgcn_mfma_f32_16x16x32_bf16(kdA[ks], bv[t4][ks], S[t], 0, 0, 0);
                  *(LAS v2u*)(lds + GS_ST + (et * 16 + fr) * 272 + (wave * 16 + 4 * fq) * 2) = (v2u){pk2(S[t][0], S[t][1]), pk2(S[t][2], S[t][3])}; } }
            SCAN_LD_AK(cn);
            LDS_BAR();
            if (tid == 0) __hip_atomic_store(prog + bh * 16, (unsigned)(c + 1), __ATOMIC_RELAXED, __HIP_MEMORY_SCOPE_AGENT);
            { const LAS float* os = (const LAS float*)(lds + GS_OS) + r * 132 + cgp * 16;
              float o[16]; float ss = 0.f;
#pragma unroll
              for (int q4 = 0; q4 < 4; ++q4) { const f32x4 v = *(const LAS f32x4*)(os + 4 * q4); o[4 * q4] = v.x; o[4 * q4 + 1] = v.y; o[4 * q4 + 2] = v.z; o[4 * q4 + 3] = v.w; ss += (v.x * v.x + v.y * v.y) + (v.z * v.z + v.w * v.w); }
              ss += __shfl_xor(ss, 1); ss += __shfl_xor(ss, 2); ss += __shfl_xor(ss, 4);
              const float rstd = 1.f / sqrtf(ss * (1.f / 128.f) + EPS);
              const size_t off = (row0 + r) * 1024 + h * 128 + cgp * 16;
              float zf[16]; unpack8(zc[0], zf); unpack8(zc[1], zf + 8);
              SCAN_LD_Z(cn);
#pragma unroll
              for (int e = 0; e < 16; ++e) o[e] = o[e] * rstd * gno[e >> 2][e & 3] * siluf_(zf[e]);
              v4u o0, o1; o0.x = pk2(o[0], o[1]); o0.y = pk2(o[2], o[3]); o0.z = pk2(o[4], o[5]); o0.w = pk2(o[6], o[7]); o1.x = pk2(o[8], o[9]); o1.y = pk2(o[10], o[11]); o1.z = pk2(o[12], o[13]); o1.w = pk2(o[14], o[15]);
              v4u* p = (v4u*)(OG + off); p[0] = o0; p[1] = o1; }
        }
        __syncthreads();
    }
}

__device__ __forceinline__ void attn_phase(const Ctx& C, char* shm, const void* vbuf) {
    const attn_body::bf16* Q = (const attn_body::bf16*)(C.ws + B_Q); const attn_body::bf16* K = (const attn_body::bf16*)(C.ws + B_K); const attn_body::bf16* V = (const attn_body::bf16*)vbuf;
    const int vcu = (C.G % 8 == 0) ? (C.bid % 8) * (C.G / 8) + C.bid / 8 : C.bid;
    for (int tr = vcu; tr < 256; tr += C.G) {
        const int b = tr >> 5, hp = (tr >> 1) & 15, vh = tr & 1, hd = hp >> 1, mp = hp & 1;
        attn_body::bf16* O = (attn_body::bf16*)(C.ws + (mp ? B_O2 : B_O1));
        for (int qb = 7; qb >= 0; --qb) attn_body::attn_unit<8>(b, hp, qb, hd * 128 + vh * 64, hd * 128 + vh * 64, Q, K, V, O, shm);
    }
}
__device__ __forceinline__ void combine_phase(const Ctx& C, const Args& a) {
    float lam;
    { const float p1 = wave_sum(a.in[7][C.lane] * a.in[8][C.lane]), p2 = wave_sum(a.in[9][C.lane] * a.in[10][C.lane]); lam = __expf(p1) - __expf(p2) + 0.2f; }
    const bf16* O1 = (const bf16*)(C.ws + B_O1); const bf16* O2 = (const bf16*)(C.ws + B_O2); bf16* OD = (bf16*)(C.ws + B_Q);
    const int cgp = C.tid & 7;
    f32x4 sg[4];
#pragma unroll
    for (int q4 = 0; q4 < 4; ++q4) sg[q4] = *(const f32x4*)(a.in[11] + cgp * 16 + q4 * 4);
    for (size_t it = (size_t)C.bid * NTHR + C.tid; it < (size_t)M * 64; it += (size_t)C.G * NTHR) {
        const size_t off = (it >> 3) * 128 + cgp * 16;
        float f1[16], f2[16];
        unpack8(*(const v4u*)(O1 + off), f1); unpack8(*(const v4u*)(O1 + off + 8), f1 + 8); unpack8(*(const v4u*)(O2 + off), f2); unpack8(*(const v4u*)(O2 + off + 8), f2 + 8);
        float ss = 0.f;
#pragma unroll
        for (int e = 0; e < 16; ++e) { f1[e] -= lam * f2[e]; ss += f1[e] * f1[e]; }
        ss += __shfl_xor(ss, 1); ss += __shfl_xor(ss, 2); ss += __shfl_xor(ss, 4);
        const float rstd = 0.8f / sqrtf(ss * (1.f / 128.f) + EPS);
#pragma unroll
        for (int e = 0; e < 16; ++e) f1[e] = f1[e] * rstd * sg[e >> 2][e & 3];
        v4u o0, o1; o0.x = pk2(f1[0], f1[1]); o0.y = pk2(f1[2], f1[3]); o0.z = pk2(f1[4], f1[5]); o0.w = pk2(f1[6], f1[7]); o1.x = pk2(f1[8], f1[9]); o1.y = pk2(f1[10], f1[11]); o1.z = pk2(f1[12], f1[13]); o1.w = pk2(f1[14], f1[15]);
        *(v4u*)(OD + off) = o0; *(v4u*)(OD + off + 8) = o1;
    }
}

__device__ __forceinline__ void post_mix_phase(const Ctx& C, const Args& a) {
    const int gw = C.bid * NWAVES + C.wave, NGW = C.G * NWAVES;
    f32x4 g1[4], g2[4];
#pragma unroll
    for (int j = 0; j < 4; ++j) { g1[j] = ((const f32x4*)a.in[15])[C.lane + 64 * j]; g2[j] = ((const f32x4*)a.in[16])[C.lane + 64 * j]; }
    bf16* XN = (bf16*)(C.ws + WS_XN);
    for (int m = gw; m < M; m += NGW) {
        f32x4* mr = (f32x4*)(a.out + (size_t)m * D) + C.lane; const f32x4* xr = (const f32x4*)(a.in[0] + (size_t)m * D) + C.lane;
        const v2u* mb = (const v2u*)((const bf16*)(C.ws + B_F) + (size_t)m * D) + C.lane;
        f32x4 v[4]; float s2 = 0.f;
#pragma unroll
        for (int j = 0; j < 4; ++j) { const v2u w = mb[64 * j]; v[j] = (f32x4){bflo(w.x), bfhi(w.x), bflo(w.y), bfhi(w.y)}; s2 += (v[j].x * v[j].x + v[j].y * v[j].y) + (v[j].z * v[j].z + v[j].w * v[j].w); }
        const float rstd = 1.f / sqrtf(wave_sum(s2) * (1.f / D) + EPS);
        float t2 = 0.f;
#pragma unroll
        for (int j = 0; j < 4; ++j) { v[j] = xr[64 * j] + v[j] * rstd * g1[j]; mr[64 * j] = v[j]; t2 += (v[j].x * v[j].x + v[j].y * v[j].y) + (v[j].z * v[j].z + v[j].w * v[j].w); }
        const float rstd2 = 1.f / sqrtf(wave_sum(t2) * (1.f / D) + EPS);
        unsigned long long* o8 = (unsigned long long*)(XN + (size_t)m * D) + C.lane;
#pragma unroll
        for (int j = 0; j < 4; ++j) { const f32x4 hh = v[j] * rstd2 * g2[j]; o8[64 * j] = (unsigned long long)pk2(hh.x, hh.y) | ((unsigned long long)pk2(hh.z, hh.w) << 32); }
    }
}
__device__ __forceinline__ void final_phase(const Ctx& C, const Args& a) {
    const int gw = C.bid * NWAVES + C.wave, NGW = C.G * NWAVES;
    f32x4 g1[4];
#pragma unroll
    for (int j = 0; j < 4; ++j) g1[j] = ((const f32x4*)a.in[21])[C.lane + 64 * j];
    for (int m = gw; m < M; m += NGW) {
        f32x4* orow = (f32x4*)(a.out + (size_t)m * D) + C.lane; const v2u* fb = (const v2u*)((const bf16*)(C.ws + B_F) + (size_t)m * D) + C.lane;
        f32x4 v[4]; float s2 = 0.f;
#pragma unroll
        for (int j = 0; j < 4; ++j) { const v2u w = fb[64 * j]; v[j] = (f32x4){bflo(w.x), bfhi(w.x), bflo(w.y), bfhi(w.y)}; s2 += (v[j].x * v[j].x + v[j].y * v[j].y) + (v[j].z * v[j].z + v[j].w * v[j].w); }
        const float rstd = 1.f / sqrtf(wave_sum(s2) * (1.f / D) + EPS);
#pragma unroll
        for (int j = 0; j < 4; ++j) orow[64 * j] = orow[64 * j] + v[j] * rstd * g1[j];
    }
}
__device__ __forceinline__ void ffn_conv_phase(const Ctx& C, const Args& a, int hf) {
    const bf16* U = (const bf16*)(C.ws + B_U); bf16* ACT = (bf16*)(C.ws + B_ACT);
    const float* cw = a.in[18]; const float* cb = a.in[19];
    for (size_t it = (size_t)C.bid * NTHR + C.tid; it < (size_t)M * 176; it += (size_t)C.G * NTHR) {
        const size_t row = it / 176; const int rem = (int)(it % 176), tl = rem >> 4, lg = rem & 15;
        const int t = (int)(row & (SEQL - 1));
        const int f0 = (hf * 11 + tl) * 128 + lg * 8;
        float ag[8], au[8];
        { const f32x4 b0 = *(const f32x4*)(cb + f0), b1 = *(const f32x4*)(cb + f0 + 4), c0 = *(const f32x4*)(cb + FF + f0), c1 = *(const f32x4*)(cb + FF + f0 + 4);
          ag[0] = b0.x; ag[1] = b0.y; ag[2] = b0.z; ag[3] = b0.w; ag[4] = b1.x; ag[5] = b1.y; ag[6] = b1.z; ag[7] = b1.w;
          au[0] = c0.x; au[1] = c0.y; au[2] = c0.z; au[3] = c0.w; au[4] = c1.x; au[5] = c1.y; au[6] = c1.z; au[7] = c1.w; }
#pragma unroll
        for (int j = 0; j < 3; ++j) { const int dt = 2 - j;
            if (t >= dt) { const bf16* up = U + (row - dt) * 2816 + tl * 256 + lg * 8;
                float fg[8], fu[8]; unpack8(*(const v4u*)up, fg); unpack8(*(const v4u*)(up + 128), fu);
                const f32x4 w0 = *(const f32x4*)(cw + j * 2 * FF + f0), w1 = *(const f32x4*)(cw + j * 2 * FF + f0 + 4), x0 = *(const f32x4*)(cw + j * 2 * FF + FF + f0), x1 = *(const f32x4*)(cw + j * 2 * FF + FF + f0 + 4);
                ag[0] += w0.x * fg[0]; ag[1] += w0.y * fg[1]; ag[2] += w0.z * fg[2]; ag[3] += w0.w * fg[3]; ag[4] += w1.x * fg[4]; ag[5] += w1.y * fg[5]; ag[6] += w1.z * fg[6]; ag[7] += w1.w * fg[7];
                au[0] += x0.x * fu[0]; au[1] += x0.y * fu[1]; au[2] += x0.z * fu[2]; au[3] += x0.w * fu[3]; au[4] += x1.x * fu[4]; au[5] += x1.y * fu[5]; au[6] += x1.z * fu[6]; au[7] += x1.w * fu[7]; } }
        v4u o; o.x = pk2(siluf_(ag[0]) * au[0], siluf_(ag[1]) * au[1]); o.y = pk2(siluf_(ag[2]) * au[2], siluf_(ag[3]) * au[3]); o.z = pk2(siluf_(ag[4]) * au[4], siluf_(ag[5]) * au[5]); o.w = pk2(siluf_(ag[6]) * au[6], siluf_(ag[7]) * au[7]);
        *(v4u*)(ACT + row * FF + f0) = o;
    }
}

constexpr int NPHASE = 15;
__global__ void __launch_bounds__(NTHR, 2) mk_fwd(Args args) {
    extern __shared__ __attribute__((aligned(16))) unsigned char lds_raw[];
    Ctx C; C.lds = (LAS unsigned char*)lds_raw; C.ws = args.ws; C.tid = threadIdx.x; C.lane = C.tid & 63; C.wave = __builtin_amdgcn_readfirstlane(C.tid >> 6); C.G = gridDim.x; C.bid = blockIdx.x;
    cg::grid_group grid = cg::this_grid();
    const int lo = args.ph_lo, hi = args.ph_hi;
    unsigned char* ws = args.ws;
#ifndef PH_MASK
#define PH_MASK 0xFFFFFFFFu
#endif
#ifndef DUP_MASK
#define DUP_MASK 0u
#endif
#define NREP(k) (((DUP_MASK >> (k)) & 1u) ? 2 : 1)
#define IN(k) (((PH_MASK >> (k)) & 1u) && lo <= (k) && (k) < hi)
    if (C.tid < 4) ((LAS unsigned*)(C.lds + 159808))[C.tid] = 0u;
    __syncthreads();
    XcdBarrier bar = xcd_barrier_post((unsigned*)ws, (volatile LAS unsigned*)(C.lds + 159808));
    if (args.ph_lo > 1000) grid.sync();
#define SEAM(k) do { if (IN(k) && IN((k) + 1)) xcd_barrier(bar); } while (0)
    typedef pg8::EpiBf16<0> EB;
    if (IN(0)) for (int rep_ = 0; rep_ < NREP(0); ++rep_) { p0_prologue(C, args); }
    SEAM(0);
    if (IN(1)) for (int rep_ = 0; rep_ < NREP(1); ++rep_) { pg8::Gemm g{(const bf16*)(ws + WS_XN), (const bf16*)(ws + WS_WING), M, 4096, D}; pg8::StaticOrder S; S.init(M, 4096, C.G, C.bid);
        EB E{(bf16*)(ws + B_GQ), 1024, nullptr, 1024, (size_t)(16 * MiB), 1.f};
        pg8::gemm_phase<EB, pg8::StaticOrder, true, true>(C.lds, g, S, E); } SEAM(1);
    if (IN(2)) for (int rep_ = 0; rep_ < NREP(2); ++rep_) { gdn_halo_preload(C); __syncthreads(); } SEAM(2);
    if (IN(3)) for (int rep_ = 0; rep_ < NREP(3); ++rep_) { gdn_local_phase(C, args, rep_ > 0); } SEAM(3);
    if (IN(4)) for (int rep_ = 0; rep_ < NREP(4); ++rep_) {
        if (C.G > 64 && C.bid < 64) gdn_scan_phase(C, args, C.bid, 64);
        else { const int idx = C.G > 64 ? C.bid - 64 : C.bid, cnt = C.G > 64 ? C.G - 64 : C.G;
            if (C.G <= 64) gdn_scan_phase(C, args, C.bid, C.G);
            late_transposes(C, args, idx, cnt);
            pg8::Gemm g{(const bf16*)(ws + WS_XN), (const bf16*)(ws + WS_WINA) + (size_t)2048 * 1024, M, 1024, D}; pg8::StaticOrder S; S.init(M, 1024, cnt, idx);
            EB E{(bf16*)((unsigned char*)args.out + 32 * MiB), 1024, nullptr, 0, 0, 1.f};
            pg8::gemm_phase<EB, pg8::StaticOrder, true, true>(C.lds, g, S, E);
            { pg8::Gemm g2{(const bf16*)(ws + WS_XN), (const bf16*)(ws + WS_WINA), M, 2048, D}; pg8::ChunkOrder S2{cnt, idx};
              pg8::EpiBf16Wait E2{EB{(bf16*)(ws + B_Q), 1024, nullptr, 1024, (size_t)(16 * MiB), attn_body::C2}, (const unsigned*)(ws + 16384)};
              pg8::gemm_phase<pg8::EpiBf16Wait, pg8::ChunkOrder, true, true>(C.lds, g2, S2, E2); } } } SEAM(4);
    if (IN(6)) for (int rep_ = 0; rep_ < NREP(6); ++rep_) { attn_phase(C, (char*)lds_raw, (const unsigned char*)args.out + 32 * MiB); } SEAM(6);
    if (IN(7)) for (int rep_ = 0; rep_ < NREP(7); ++rep_) { combine_phase(C, args);
        pg8::Gemm g{(const bf16*)(ws + WS_XN), (const bf16*)(ws + WS_WINX), M, 2048, D}; pg8::StaticOrder S; S.init(M, 2048, C.G, C.bid);
        EB E{(bf16*)(ws + B_GATES), 2048, nullptr, 0, 0, 1.f};
        pg8::gemm_phase<EB, pg8::StaticOrder, true, true>(C.lds, g, S, E); } SEAM(7);
    if (IN(8)) for (int rep_ = 0; rep_ < NREP(8); ++rep_) { pg8::Gemm g{(const bf16*)args.out, (const bf16*)(ws + WS_WBA), M, 1024, D}; pg8::StaticOrder S; S.init(M, 1024, C.G, C.bid);
        pg8::EpiGate<false> E{(bf16*)(ws + B_MRG), (const bf16*)(ws + B_GATES), 0};
        pg8::gemm_phase<pg8::EpiGate<false>, pg8::StaticOrder, true, true>(C.lds, g, S, E); } SEAM(8);
    if (IN(9)) for (int rep_ = 0; rep_ < NREP(9); ++rep_) { pg8::Gemm g{(const bf16*)(ws + B_Q), (const bf16*)(ws + WS_WBB), M, 1024, D}; pg8::StaticOrder S; S.init(M, 1024, C.G, C.bid);
        pg8::EpiGate<true> E{(bf16*)(ws + B_MRG), (const bf16*)(ws + B_GATES), 1024};
        pg8::gemm_phase<pg8::EpiGate<true>, pg8::StaticOrder, true, true>(C.lds, g, S, E); } SEAM(9);
    if (IN(10)) for (int rep_ = 0; rep_ < NREP(10); ++rep_) { pg8::Gemm g{(const bf16*)(ws + B_MRG), (const bf16*)(ws + WS_WOUT), M, 1024, D}; pg8::StaticOrder S; S.init(M, 1024, C.G, C.bid);
        EB E{(bf16*)(ws + B_F), 1024, nullptr, 0, 0, 1.f};
        pg8::gemm_phase<EB, pg8::StaticOrder, true, true>(C.lds, g, S, E); } SEAM(10);
    if (IN(11)) for (int rep_ = 0; rep_ < NREP(11); ++rep_) { post_mix_phase(C, args); } SEAM(11);
    if (IN(12)) for (int rep_ = 0; rep_ < NREP(12); ++rep_) { pg8::Gemm g{(const bf16*)(ws + WS_XN) - 2 * 1024, (const bf16*)(ws + WS_WUP), 65 * 256, 5632, D, (size_t)254 * 1024 * 2}; pg8::StaticOrder S; S.init(65 * 256, 5632, C.G, C.bid);
        pg8::EpiConvAct E{(bf16*)(ws + B_ACT), args.in[18], args.in[19], C.lds + 131072};
        pg8::gemm_phase<pg8::EpiConvAct, pg8::StaticOrder, true, true>(C.lds, g, S, E); } SEAM(12);
    if (IN(13)) for (int rep_ = 0; rep_ < NREP(13); ++rep_) { pg8::Gemm g{(const bf16*)(ws + B_ACT), (const bf16*)(ws + WS_WDN), M, 1024, FF}; pg8::StaticOrder S; S.init(M, 1024, C.G, C.bid);
        EB E{(bf16*)(ws + B_F), 1024, nullptr, 0, 0, 1.f};
        pg8::gemm_phase<EB, pg8::StaticOrder, true, true>(C.lds, g, S, E); } SEAM(13);
    if (IN(14)) for (int rep_ = 0; rep_ < NREP(14); ++rep_) { final_phase(C, args); }
#undef IN
#undef SEAM
}

extern "C" void kernel_launch(void* const* d_in, const int* in_sizes, int n_in, void* d_out, int out_size, void* d_ws, size_t ws_size, hipStream_t stream) {
    static int grid = 0;
    if (grid == 0) {
        int dev = 0, cus = 0, per_cu = 0;
        hipGetDevice(&dev); hipDeviceGetAttribute(&cus, hipDeviceAttributeMultiprocessorCount, dev);
        hipFuncSetAttribute((const void*)mk_fwd, hipFuncAttributeMaxDynamicSharedMemorySize, LDS_TOTAL);
        hipOccupancyMaxActiveBlocksPerMultiprocessor(&per_cu, (const void*)mk_fwd, NTHR, LDS_TOTAL);
        (void)hipGetLastError();
        if (per_cu < 1) per_cu = 1;
        grid = cus;
        if (grid > 256) grid = 256;
    }
    (void)hipMemsetAsync(d_ws, 0, 32768, stream);
    Args a{};
    for (int i = 0; i < 22; ++i) a.in[i] = (const float*)d_in[i];
    a.out = (float*)d_out; a.ws = (unsigned char*)d_ws;
#if MK_PER_PHASE
    for (int p = 0; p < NPHASE; ++p) { a.ph_lo = p; a.ph_hi = p + 1; hipLaunchKernelGGL(mk_fwd, dim3(grid), dim3(NTHR), LDS_TOTAL, stream, a); }
#else
    a.ph_lo = 0; a.ph_hi = NPHASE;
    void* kargs[] = {&a};
    hipError_t e = hipLaunchCooperativeKernel((const void*)mk_fwd, dim3(grid), dim3(NTHR), kargs, LDS_TOTAL, stream);
    if (e != hipSuccess) fprintf(stderr, "cooperative launch failed: %s (grid %d)\n", hipGetErrorString(e), grid);
#endif
}
```

```cpp
#include <hip/hip_runtime.h>
#include <hip/hip_cooperative_groups.h>
#include <cstdio>
#include <cstdint>

namespace pg8 {
#define PG8_LAS __attribute__((address_space(3)))
typedef unsigned short bf16_t;
typedef short bf16x8 __attribute__((ext_vector_type(8)));
typedef float f32x4 __attribute__((ext_vector_type(4)));
typedef unsigned u32x4 __attribute__((ext_vector_type(4)));
constexpr int BM = 256, BK = 64, HALF = 128, HTB = HALF * BK * 2  , STAGE_BYTES = 8 * HTB, NXCD = 8, WGM = 8;

__host__ __device__ __forceinline__ int lds_byte(int r, int c) { const int st = (r >> 4) * 2 + (c >> 5), rr = r & 15, cc = c & 31, ob = rr * 64 + cc * 2; return st * 1024 + (ob ^ (((ob >> 9) & 1) << 5)); }
__host__ __device__ __forceinline__ void stage_rc(int b, int& R, int& C) { const int st = b / 1024, sb = b % 1024, swz = sb ^ (((sb >> 9) & 1) << 5); R = (st >> 1) * 16 + swz / 64; C = (st & 1) * 32 + (swz % 64) / 2; }
__host__ __device__ __forceinline__ int perm32(int rho) { const int n = rho >> 4, i = rho & 15; return 8 * (i >> 2) + 4 * n + (i & 3); }

struct Unit { int pm, pn; };
struct Gemm { const bf16_t* A; const bf16_t* Bt; int M, N, K; size_t a_tstep; };

struct StaticOrder {
    int nM, nN, nwg, G, c;
    __host__ __device__ void init(int M, int N, int G_, int c_) { nM = M / BM; nN = N / BM; nwg = nM * nN; G = G_; c = c_; }
    __host__ __device__ bool next(int i, Unit& u) const {
        const long L = (long)i * G + c; if (L >= nwg) return false;
        int wgid = (int)L; { const int q = nwg / NXCD, r = nwg % NXCD, xcd = wgid % NXCD, off = wgid / NXCD; wgid = (xcd < r ? xcd * (q + 1) : r * (q + 1) + (xcd - r) * q) + off; }
        const int nig = WGM * nN, gid = wgid / nig, fm = gid * WGM, gsz = (nM - fm) < WGM ? (nM - fm) : WGM;
        u.pm = fm + ((wgid % nig) % gsz); u.pn = (wgid % nig) / gsz; return true;
    }
    __device__ __forceinline__ void a_ready(const Unit&) const {}
    __device__ __forceinline__ void done(const Unit&) const {}
};

__device__ __forceinline__ unsigned cvt_pk_bf16(float lo, float hi) { unsigned r; asm volatile("v_cvt_pk_bf16_f32 %0, %1, %2" : "=v"(r) : "v"(lo), "v"(hi)); return r; }
typedef float f32x2 __attribute__((ext_vector_type(2)));
__device__ __forceinline__ f32x2 gelu_pk(f32x2 v) {
    const f32x2 av = __builtin_elementwise_abs(v), d = av * 0.2316418882f + 1.0f;
    f32x2 t; t.x = __builtin_amdgcn_rcpf(d.x); t.y = __builtin_amdgcn_rcpf(d.y);
    f32x2 q = t * 0.5307027145f + (-0.7265760135f); q = q * t + 0.7107068705f; q = q * t + (-0.142248368f); q = q * t + 0.127414796f; q = q * t;
    const f32x2 s = (v * v) * (-0.72134752044f);
    f32x2 e; e.x = __builtin_amdgcn_exp2f(s.x); e.y = __builtin_amdgcn_exp2f(s.y);
    const f32x2 m = v * (q * e), r = v - m;
    f32x2 o; o.x = v.x < 0.f ? m.x : r.x; o.y = v.y < 0.f ? m.y : r.y; return o;
}

template <int ACT  > struct EpiBf16 {
    static constexpr bool PERM = true, AFTER_DRAIN = false; static_assert(ACT == 0 || ACT == 1, "EpiBf16: ACT is 0 (none) or 1 (gelu_pk)");
    bf16_t* O; int ldc; const float* bias; int split_cols; size_t split_stride; float scale0;
    __device__ __forceinline__ void operator()(const f32x4 (&acc)[2][2][4][2], const Unit& u, int wr, int wc, int fr, int fq) const {
        const int row0 = u.pm * BM + wr * 64 + fr; int colt = u.pn * BM; bf16_t* base = O;
        float sc = 1.f; if (split_cols) { const int t = colt / split_cols; base += (size_t)t * split_stride; colt -= t * split_cols; if (t == 0) sc = scale0; }
        const int col0 = colt + wc * 32 + 8 * fq, bcol0 = u.pn * BM + wc * 32 + 8 * fq;
        f32x4 bv[2][2];
#pragma unroll
        for (int bj = 0; bj < 2; ++bj)
#pragma unroll
            for (int n = 0; n < 2; ++n) bv[bj][n] = bias ? *(const f32x4*)(bias + bcol0 + bj * HALF + 4 * n) : (f32x4){0.f, 0.f, 0.f, 0.f};
#pragma unroll
        for (int ai = 0; ai < 2; ++ai)
#pragma unroll
            for (int m = 0; m < 4; ++m) { bf16_t* rowp = base + (size_t)(row0 + ai * HALF + m * 16) * ldc + col0;
#pragma unroll
                for (int bj = 0; bj < 2; ++bj) { f32x4 v0 = acc[ai][bj][m][0] + bv[bj][0], v1 = acc[ai][bj][m][1] + bv[bj][1];
                    if (ACT == 1) { f32x2 a = gelu_pk((f32x2){v0[0], v0[1]}), b = gelu_pk((f32x2){v0[2], v0[3]}), c = gelu_pk((f32x2){v1[0], v1[1]}), d = gelu_pk((f32x2){v1[2], v1[3]});
                        v0 = (f32x4){a.x, a.y, b.x, b.y}; v1 = (f32x4){c.x, c.y, d.x, d.y}; }
                    v0 = v0 * sc; v1 = v1 * sc; u32x4 w; w.x = cvt_pk_bf16(v0[0], v0[1]); w.y = cvt_pk_bf16(v0[2], v0[3]); w.z = cvt_pk_bf16(v1[0], v1[1]); w.w = cvt_pk_bf16(v1[2], v1[3]);
                    *(u32x4*)(rowp + bj * HALF) = w; } }
    }
};
template <class Epi, class Sched, bool ALIGN_EPI = false, bool SP2 = false>
__device__ __forceinline__ void gemm_phase(PG8_LAS unsigned char* lds, const Gemm g, const Sched& S, const Epi& E) {
    const int tid = threadIdx.x, wid = __builtin_amdgcn_readfirstlane(tid >> 6), lane = tid & 63, wr = wid >> 2, wc = wid & 3, fr = lane & 15, fq = lane >> 4;
    const int K = g.K, nt = K / BK;
    unsigned voffA[2], voffB[2];
#pragma unroll
    for (int i = 0; i < 2; ++i) { int R, C; stage_rc(tid * 16 + i * 8192, R, C); const int Rb = Epi::PERM ? ((R & ~31) + perm32(R & 31)) : R;
        voffA[i] = (unsigned)(R * K + C) * 2u; voffB[i] = (unsigned)(Rb * K + C) * 2u; }
    const size_t kstep = (size_t)(BK * 2);
    const size_t hstep = (size_t)HALF * K * 2;
    const size_t tstep = 2 * hstep;
    const size_t tstepA = g.a_tstep ? g.a_tstep : tstep;
    const unsigned ldsw = (unsigned)wid * 1024u;
    const int aoff = lds_byte(wr * 64 + fr, fq * 8), boff = lds_byte(wc * 32 + fr, fq * 8);
#define PG8_SA(b, h) (((b) * 2 + (h)) * HTB)
#define PG8_SB(b, h) ((4 + (b) * 2 + (h)) * HTB)
#define PG8_STAGE(bufoff, gbase, voff) do { _Pragma("unroll") for (int _i = 0; _i < 2; ++_i) \
        __builtin_amdgcn_global_load_lds((const unsigned*)((const char*)(gbase) + (voff)[_i]), (PG8_LAS unsigned*)(lds + (bufoff) + ldsw + _i * 8192), 16, 0, 0); } while (0)
#define PG8_LDA(dst, b, h) do { _Pragma("unroll") for (int m = 0; m < 4; ++m) _Pragma("unroll") for (int k = 0; k < 2; ++k) dst[m][k] = *(const PG8_LAS bf16x8*)(lds + PG8_SA(b, h) + aoff + m * 2048 + k * 1024); } while (0)
#define PG8_LDB(dst, b, h) do { _Pragma("unroll") for (int n = 0; n < 2; ++n) _Pragma("unroll") for (int k = 0; k < 2; ++k) dst[n][k] = *(const PG8_LAS bf16x8*)(lds + PG8_SB(b, h) + boff + n * 2048 + k * 1024); } while (0)
#define PG8_MMA(ai, bj, At, Bt) do { __builtin_amdgcn_s_setprio(1); _Pragma("unroll") for (int m = 0; m < 4; ++m) _Pragma("unroll") for (int n = 0; n < 2; ++n) _Pragma("unroll") for (int k = 0; k < 2; ++k) \
        acc[ai][bj][m][n] = __builtin_amdgcn_mfma_f32_16x16x32_bf16(Bt[n][k], At[m][k], acc[ai][bj][m][n], 0, 0, 0); __builtin_amdgcn_s_setprio(0); } while (0)
#define PG8_WAIT_V(n) asm volatile("s_waitcnt vmcnt(" #n ")" ::: "memory")
#define PG8_WAIT_L(n) asm volatile("s_waitcnt lgkmcnt(" #n ")" ::: "memory")
#define PG8_BAR __builtin_amdgcn_s_barrier()
#define PG8_SCHED __builtin_amdgcn_sched_barrier(0)
    Unit cur, nxt; int ui = 0;
    if (!S.next(0, cur)) return;
    f32x4 acc[2][2][4][2];
#pragma unroll
    for (int a = 0; a < 2; ++a)
#pragma unroll
        for (int b = 0; b < 2; ++b)
#pragma unroll
            for (int m = 0; m < 4; ++m)
#pragma unroll
                for (int n = 0; n < 2; ++n) acc[a][b][m][n] = (f32x4){0.f, 0.f, 0.f, 0.f};
    bf16x8 At[4][2], B0[2][2], B1[2][2];
    const char* cA = (const char*)g.A + (size_t)cur.pm * tstepA; const char* cB = (const char*)g.Bt + (size_t)cur.pn * tstep;
    S.a_ready(cur);
    if constexpr (SP2) {
        PG8_STAGE(PG8_SB(0, 0), cB, voffB); PG8_STAGE(PG8_SB(0, 1), cB + hstep, voffB); PG8_STAGE(PG8_SA(0, 0), cA, voffA); PG8_STAGE(PG8_SA(0, 1), cA + hstep, voffA);
        if (wr == 1) PG8_BAR;
        PG8_WAIT_V(2); PG8_BAR;
        PG8_STAGE(PG8_SB(1, 0), cB + kstep, voffB); PG8_STAGE(PG8_SA(1, 0), cA + kstep, voffA); PG8_STAGE(PG8_SB(1, 1), cB + hstep + kstep, voffB);
        PG8_WAIT_V(6); PG8_BAR;
    } else {
        PG8_STAGE(PG8_SB(0, 0), cB, voffB); PG8_STAGE(PG8_SA(0, 0), cA, voffA); PG8_STAGE(PG8_SB(0, 1), cB + hstep, voffB); PG8_STAGE(PG8_SA(0, 1), cA + hstep, voffA);
        if (wr == 1) PG8_BAR;
        PG8_WAIT_V(4); PG8_BAR;
        PG8_STAGE(PG8_SB(1, 0), cB + kstep, voffB); PG8_STAGE(PG8_SA(1, 0), cA + kstep, voffA); PG8_STAGE(PG8_SB(1, 1), cB + hstep + kstep, voffB);
        PG8_WAIT_V(6); PG8_BAR;
    }
    for (;;) {
        const bool has_next = S.next(ui + 1, nxt);
        const char* nA = has_next ? (const char*)g.A + (size_t)nxt.pm * tstepA : cA; const char* nB = has_next ? (const char*)g.Bt + (size_t)nxt.pn * tstep : cB;
        for (int t = 0; t < nt; t += 2) {
            const bool last = (t == nt - 2);
            const char* a1 = cA + (size_t)(t + 1) * kstep;
            const char* a2 = last ? nA : cA + (size_t)(t + 2) * kstep; const char* b2 = last ? nB : cB + (size_t)(t + 2) * kstep;
            const char* a3 = a2 + kstep; const char* b3 = b2 + kstep;
            if (last && has_next) S.a_ready(nxt);
            if constexpr (SP2) {
            PG8_LDB(B0, 0, 0); PG8_LDB(B1, 0, 1); PG8_SCHED; PG8_LDA(At, 0, 0); PG8_STAGE(PG8_SA(1, 1), a1 + hstep, voffA);
            PG8_WAIT_V(8); PG8_WAIT_L(0); PG8_BAR; PG8_MMA(0, 0, At, B0); PG8_MMA(0, 1, At, B1); PG8_BAR; PG8_SCHED;
            PG8_LDA(At, 0, 1); PG8_STAGE(PG8_SB(0, 0), b2, voffB); PG8_STAGE(PG8_SB(0, 1), b2 + hstep, voffB); PG8_STAGE(PG8_SA(0, 0), a2, voffA);
            PG8_WAIT_V(8); PG8_WAIT_L(0); PG8_BAR; PG8_MMA(1, 0, At, B0); PG8_MMA(1, 1, At, B1); PG8_BAR; PG8_SCHED;
            PG8_LDB(B0, 1, 0); PG8_LDB(B1, 1, 1); PG8_SCHED; PG8_LDA(At, 1, 0); PG8_STAGE(PG8_SA(0, 1), a2 + hstep, voffA);
            PG8_WAIT_V(8); PG8_WAIT_L(0); PG8_BAR; PG8_MMA(0, 0, At, B0); PG8_MMA(0, 1, At, B1); PG8_BAR; PG8_SCHED;
            PG8_LDA(At, 1, 1); PG8_STAGE(PG8_SB(1, 0), b3, voffB); PG8_STAGE(PG8_SB(1, 1), b3 + hstep, voffB); PG8_STAGE(PG8_SA(1, 0), a3, voffA);
            PG8_WAIT_V(8); PG8_WAIT_L(0); PG8_BAR; PG8_MMA(1, 0, At, B0); PG8_MMA(1, 1, At, B1); PG8_BAR; PG8_SCHED;
            } else {
            PG8_LDB(B0, 0, 0); PG8_SCHED; PG8_LDA(At, 0, 0); PG8_STAGE(PG8_SA(1, 1), a1 + hstep, voffA);
            PG8_WAIT_L(8); PG8_BAR; PG8_WAIT_L(0); PG8_MMA(0, 0, At, B0); PG8_BAR; PG8_SCHED;
            PG8_LDB(B1, 0, 1); PG8_STAGE(PG8_SB(0, 0), b2, voffB);
            PG8_BAR; PG8_WAIT_L(0); PG8_MMA(0, 1, At, B1); PG8_BAR;
            PG8_LDA(At, 0, 1); PG8_STAGE(PG8_SA(0, 0), a2, voffA);
            PG8_BAR; PG8_WAIT_L(0); PG8_MMA(1, 0, At, B0); PG8_BAR; PG8_SCHED;
            PG8_STAGE(PG8_SB(0, 1), b2 + hstep, voffB);
            PG8_WAIT_V(6); PG8_BAR; PG8_MMA(1, 1, At, B1); PG8_BAR;
            PG8_LDB(B0, 1, 0); PG8_SCHED; PG8_LDA(At, 1, 0); PG8_STAGE(PG8_SA(0, 1), a2 + hstep, voffA);
            PG8_WAIT_L(8); PG8_BAR; PG8_WAIT_L(0); PG8_MMA(0, 0, At, B0); PG8_BAR; PG8_SCHED;
            PG8_LDB(B1, 1, 1); PG8_STAGE(PG8_SB(1, 0), b3, voffB);
            PG8_BAR; PG8_WAIT_L(0); PG8_MMA(0, 1, At, B1); PG8_BAR;
            PG8_LDA(At, 1, 1); PG8_STAGE(PG8_SA(1, 0), a3, voffA);
            PG8_BAR; PG8_WAIT_L(0); PG8_MMA(1, 0, At, B0); PG8_BAR; PG8_SCHED;
            PG8_STAGE(PG8_SB(1, 1), b3 + hstep, voffB);
            PG8_WAIT_V(6); PG8_BAR; PG8_MMA(1, 1, At, B1); PG8_BAR;
            }
        }
        if constexpr (ALIGN_EPI) { if (wr == 0) PG8_BAR; }
        if constexpr (!Epi::AFTER_DRAIN) { E(acc, cur, wr, wc, fr, fq); S.done(cur); }
        if (!has_next) break;
#pragma unroll
        for (int a = 0; a < 2; ++a)
#pragma unroll
            for (int b = 0; b < 2; ++b)
#pragma unroll
                for (int m = 0; m < 4; ++m)
#pragma unroll
                    for (int n = 0; n < 2; ++n) acc[a][b][m][n] = (f32x4){0.f, 0.f, 0.f, 0.f};
        cur = nxt; cA = nA; cB = nB; ++ui;
        if constexpr (ALIGN_EPI) { if (wr == 1) PG8_BAR; }
    }
    PG8_WAIT_V(0);
    if constexpr (!ALIGN_EPI) { if (wr == 0) PG8_BAR; }
    PG8_BAR;
    if constexpr (Epi::AFTER_DRAIN) { E.fused(acc, cur, wr, wc, fr, fq, lds, wid, lane); S.done(cur); }
#undef PG8_SA
#undef PG8_SB
#undef PG8_STAGE
#undef PG8_LDA
#undef PG8_LDB
#undef PG8_MMA
#undef PG8_WAIT_V
#undef PG8_WAIT_L
#undef PG8_BAR
#undef PG8_SCHED
}
}

#ifndef PG8_SP2
#define PG8_SP2 true
#endif
#ifndef PG8_ALIGN
#define PG8_ALIGN true
#endif
#include <hip/hip_bf16.h>
#include <cmath>
namespace attn_body {
using bf16=__hip_bfloat16;
using bf16x8=__attribute__((ext_vector_type(8)))short;
using s16x4=__attribute__((ext_vector_type(4)))short;
using f32x16=__attribute__((ext_vector_type(16)))float;
using u32x4=__attribute__((ext_vector_type(4)))unsigned;
constexpr int BATCH=8,NHEAD=16,SEQ=2048,D=64,DM=NHEAD*D;
constexpr int NW=8,QBLK=32,QB=QBLK*NW,KVBLK=64,NQB=SEQ/QB;
constexpr int ATTN_PITCH=DM, ATTN_UNIT_ROWS=QB;
__device__ __forceinline__ int crow(int r,int hi){return (r&3)+8*(r>>2)+4*hi;}
#define SBAR() __builtin_amdgcn_sched_barrier(0)
__device__ __forceinline__ void cmask(f32x16&p0,f32x16&p1,int jb,int qrel,int hi){
  const float NEG=-INFINITY; int kb=64*jb+4*hi;
  #pragma unroll
  for(int r=0;r<16;++r){int kv=kb+(r&3)+8*(r>>2); if(kv>qrel)p0[r]=NEG; if(kv+32>qrel)p1[r]=NEG;}
}

constexpr int NSLOT=3, SLOTB=8192;
constexpr int LDS_K=0, LDS_V=NSLOT*SLOTB, LDS_WS=2*NSLOT*SLOTB, LDS_OST=LDS_WS+NW*64*4, LDS_BYTES=LDS_OST+NW*4096;
constexpr float C2=0.125f*1.4426950408889634f;
__device__ __forceinline__ void glds16(const void*gsrc,unsigned lds_dst){unsigned keep;
  asm volatile("s_mov_b32 %0, m0\n\ts_mov_b32 m0, %2\n\ts_nop 0\n\tglobal_load_lds_dwordx4 %1, off\n\ts_mov_b32 m0, %0":"=&s"(keep):"v"(gsrc),"s"(lds_dst):"memory");}
__device__ __forceinline__ float max3f(float a,float b,float c){float r;asm("v_max3_f32 %0, %1, %2, %3":"=v"(r):"v"(a),"v"(b),"v"(c));return r;}
__device__ __forceinline__ float max2f(float a,float b){float r;asm("v_max_f32_e32 %0, %1, %2":"=v"(r):"v"(a),"v"(b));return r;}
__device__ __forceinline__ float fadd_s(float a,float b){float r;asm("v_add_f32_e32 %0, %1, %2":"=v"(r):"v"(a),"v"(b));return r;}
__device__ __forceinline__ float fsub_s(float a,float b){float r;asm("v_sub_f32_e32 %0, %1, %2":"=v"(r):"v"(a),"v"(b));return r;}
typedef float f32x2_t __attribute__((ext_vector_type(2))); typedef __bf16 bf16x2_t __attribute__((ext_vector_type(2)));
__device__ __forceinline__ unsigned cvtpk_s(float lo,float hi){f32x2_t v={lo,hi};bf16x2_t b=__builtin_convertvector(v,bf16x2_t);return __builtin_bit_cast(unsigned,b);}
#define WAIT_BAR(N) asm volatile("s_waitcnt vmcnt(" #N ") lgkmcnt(0)\n\ts_barrier":::"memory")

__device__ __forceinline__ void qkt(f32x16&p0,f32x16&p1,const char*Kslot,const bf16x8*qr,const f32x16&negm,int r32,int hi){
  const char*kb=Kslot+hi*1024+r32*16;
  #pragma unroll
  for(int d0=0;d0<4;++d0){
    const bf16x8 b0=*reinterpret_cast<const bf16x8*>(kb+d0*2048);
    const bf16x8 b1=*reinterpret_cast<const bf16x8*>(kb+d0*2048+512);
    if(d0==0){p0=__builtin_amdgcn_mfma_f32_32x32x16_bf16(b0,qr[0],negm,0,0,0);p1=__builtin_amdgcn_mfma_f32_32x32x16_bf16(b1,qr[0],negm,0,0,0);}
    else{p0=__builtin_amdgcn_mfma_f32_32x32x16_bf16(b0,qr[d0],p0,0,0,0);p1=__builtin_amdgcn_mfma_f32_32x32x16_bf16(b1,qr[d0],p1,0,0,0);}}
}
typedef __attribute__((address_space(3))) const char* lds_cptr;
typedef short v4i16_t __attribute__((ext_vector_type(4)));
__device__ __forceinline__ void kload8(bf16x8*kf,lds_cptr kp){
  kf[0]=*(const __attribute__((address_space(3))) bf16x8*)(kp);      kf[1]=*(const __attribute__((address_space(3))) bf16x8*)(kp+512);
  kf[2]=*(const __attribute__((address_space(3))) bf16x8*)(kp+2048); kf[3]=*(const __attribute__((address_space(3))) bf16x8*)(kp+2560);
  kf[4]=*(const __attribute__((address_space(3))) bf16x8*)(kp+4096); kf[5]=*(const __attribute__((address_space(3))) bf16x8*)(kp+4608);
  kf[6]=*(const __attribute__((address_space(3))) bf16x8*)(kp+6144); kf[7]=*(const __attribute__((address_space(3))) bf16x8*)(kp+6656);
}
__device__ __forceinline__ void kload2(bf16x8*kf,lds_cptr kp,int j){ kf[2*j]=*(const __attribute__((address_space(3))) bf16x8*)(kp+j*2048); kf[2*j+1]=*(const __attribute__((address_space(3))) bf16x8*)(kp+j*2048+512); }
__device__ __forceinline__ s16x4 vtr(lds_cptr p){ return __builtin_bit_cast(s16x4,__builtin_amdgcn_ds_read_tr16_b64_v4i16((__attribute__((address_space(3))) v4i16_t*)p)); }
__device__ __forceinline__ float rowmax(const f32x16&p0,const f32x16&p1){
  float a=max3f(p0[0],p0[1],p1[0]),b=max3f(p0[2],p0[3],p1[1]);a=max3f(a,p1[2],p1[3]);
  #pragma unroll
  for(int r=4;r<16;r+=4){a=max3f(a,p0[r],p0[r+1]);b=max3f(b,p0[r+2],p0[r+3]);a=max3f(a,p1[r],p1[r+1]);b=max3f(b,p1[r+2],p1[r+3]);}
  const float m=max2f(a,b);
  auto rr=__builtin_amdgcn_permlane32_swap(__float_as_uint(m),__float_as_uint(m),false,false);
  return max2f(__uint_as_float(rr[0]),__uint_as_float(rr[1]));
}
__device__ __forceinline__ void pv(f32x16*o,int vb,bf16x8 pa0,bf16x8 pa1,bf16x8 pa2,bf16x8 pa3){
  #pragma unroll
  for(int d0=0;d0<2;++d0){s16x4 lo[4],hi[4];
    #pragma unroll
    for(int ks=0;ks<4;++ks){
      asm volatile("ds_read_b64_tr_b16 %0,%1 offset:%c2":"=&v"(lo[ks]):"v"(vb),"i"(d0*4096+ks*1024):"memory");
      asm volatile("ds_read_b64_tr_b16 %0,%1 offset:%c2":"=&v"(hi[ks]):"v"(vb),"i"(d0*4096+ks*1024+512):"memory");}
    asm volatile("s_waitcnt lgkmcnt(0)":::"memory");SBAR();
    #define PK(k) (bf16x8){lo[k][0],lo[k][1],lo[k][2],lo[k][3],hi[k][0],hi[k][1],hi[k][2],hi[k][3]}
    o[d0]=__builtin_amdgcn_mfma_f32_32x32x16_bf16(pa0,PK(0),o[d0],0,0,0);
    o[d0]=__builtin_amdgcn_mfma_f32_32x32x16_bf16(pa1,PK(1),o[d0],0,0,0);
    o[d0]=__builtin_amdgcn_mfma_f32_32x32x16_bf16(pa2,PK(2),o[d0],0,0,0);
    o[d0]=__builtin_amdgcn_mfma_f32_32x32x16_bf16(pa3,PK(3),o[d0],0,0,0);
    #undef PK
  }
}

#ifndef ATTN_STORE16
#define ATTN_STORE16(p,v) (*(u32x4*)(p)=(v))
#endif
template<int THRL> __device__ __forceinline__ void attn_unit(int b,int h,int qb,int vcol,int ocol,const bf16*Q,const bf16*__restrict__ K,const bf16*__restrict__ V,bf16*O,char*shm){
  int tid_=threadIdx.x; asm volatile("":"+v"(tid_)); const int tid=tid_,lane=tid&63,r32=lane&31,hi=lane>>5; const int wid=__builtin_amdgcn_readfirstlane(tid>>6);
  const long rowbase=(long)b*SEQ; const int q0=qb*QB;
  const bf16*Qw=Q+(rowbase+q0+wid*QBLK)*DM+h*D;
  const bf16*Kh=K+rowbase*DM+h*D,*Vh=V+rowbase*DM+vcol;
  const unsigned lds0=(unsigned)(uintptr_t)shm;
  float*wsf=(float*)(shm+LDS_WS)+wid*64;
  const bf16*ksrc=Kh+(long)lane*DM+wid*8;
  const bf16*vsrc=Vh+(long)(16*(wid&3)+(lane>>2))*DM+(wid>>2)*32+(lane&3)*8;
  const unsigned kdst=lds0+LDS_K+wid*1024, vdst=lds0+LDS_V+wid*1024;
  #define DMA_K(t,slot) glds16(ksrc+(long)(t)*KVBLK*DM,(unsigned)__builtin_amdgcn_readfirstlane(kdst+(slot)))
  #define DMA_V(t,slot) glds16(vsrc+(long)(t)*KVBLK*DM,(unsigned)__builtin_amdgcn_readfirstlane(vdst+(slot)))
  const int vb0=(int)(lds0+LDS_V)+((lane>>4)&1)*32+(lane&3)*8+(4*hi+((lane&15)>>2))*64;
  const char*Kbase=shm+LDS_K; bf16x8 kf[8];
  const lds_cptr shm3=(lds_cptr)shm; const lds_cptr kp0=shm3+LDS_K+hi*1024+r32*16; const lds_cptr vp0=shm3+LDS_V+((lane>>4)&1)*32+(lane&3)*8+(4*hi+((lane&15)>>2))*64;
  const int NT=(q0+QB)/KVBLK;
  DMA_K(0,0);DMA_V(0,0);DMA_K(1,SLOTB);
  bf16x8 qr[4];
  #pragma unroll
  for(int d0=0;d0<4;++d0)qr[d0]=*reinterpret_cast<const bf16x8*>(&Qw[(long)r32*DM+d0*16+hi*8]);
  float mhat=0.f,l_reg=0.f;f32x16 o[2];o[0]=f32x16{};o[1]=f32x16{};f32x16 negm=f32x16{};asm volatile("":"+v"(negm));
  const int qrel=wid*QBLK+r32;
  #define CMASK(P0,P1,t) do{int jb_=(t)-(NT-4); if(jb_>=0)cmask(P0,P1,jb_,qrel,hi);}while(0)
  bool resc=false;
  #define START(P0,P1) do{ const float rm=rowmax(P0,P1); resc=false; \
    { const float dl=rm; mhat=fadd_s(mhat,dl); \
      _Pragma("unroll") for(int r=0;r<16;++r){P0[r]=fsub_s(P0[r],dl);P1[r]=fsub_s(P1[r],dl);} \
      _Pragma("unroll") for(int r=0;r<16;++r)negm[r]=-mhat; asm volatile("":"+v"(negm)); } \
    _Pragma("unroll") for(int r=0;r<16;++r)P0[r]=__builtin_amdgcn_exp2f(P0[r]); }while(0)
  #define RESC() do{ if(resc){ asm volatile("s_waitcnt lgkmcnt(0)":::"memory"); \
      _Pragma("unroll") for(int d_=0;d_<2;++d_) _Pragma("unroll") for(int r=0;r<16;++r)o[d_][r]*=wsf[crow(r,hi)]; } }while(0)
  f32x16 pA0,pA1,pB0,pB1;
  int sl_prev=0,sl_cur=0,sl_next=SLOTB;
  #define ROT() do{sl_prev=sl_cur;sl_cur=sl_next;sl_next=(sl_next==(NSLOT-1)*SLOTB)?0:sl_next+SLOTB;}while(0)
  DMA_K(2,2*SLOTB);
  WAIT_BAR(3);
  qkt(pA0,pA1,Kbase,qr,negm,r32,hi);asm volatile("s_nop 15\n\ts_nop 7":"+v"(pA0),"+v"(pA1));CMASK(pA0,pA1,0);
  START(pA0,pA1);
  _Pragma("unroll") for(int r=0;r<16;++r)pA1[r]=__builtin_amdgcn_exp2f(pA1[r]);
  WAIT_BAR(0);
  DMA_K(3,0);DMA_V(1,SLOTB);
  ROT();
  kload8(kf,kp0+sl_cur);
  WAIT_BAR(2);
  s16x4 vlo[8],vhi[8]; u32x4 pw0,pw1,pw2,pw3;
  #define PKW(P,B) cvtpk_s(P[B],P[B+1])
  #define PAF(k) __builtin_bit_cast(bf16x8,pw##k)
  #define VFR(i) (bf16x8){vlo[i][0],vlo[i][1],vlo[i][2],vlo[i][3],vhi[i][0],vhi[i][1],vhi[i][2],vhi[i][3]}
  #define PIN(x) asm volatile("":"+v"(x))
  #define MX3(a,b,c) __builtin_fmaxf(__builtin_fmaxf((a),(b)),(c))
  #define GAPA(MF,A0,A1,A2,A3,W0,W1,PW) do{ MF; sacc+=A0; sacc+=A1; sacc+=A2; sacc+=A3; PIN(sacc); W0; W1; PIN(PW); SBAR(); }while(0)
  #define EX(v) __builtin_amdgcn_exp2f(v)
  #define GAPB(MF,X,B) do{ MF; X[B]=EX(X[B]); X[B+1]=EX(X[B+1]); X[B+2]=EX(X[B+2]); X[B+3]=EX(X[B+3]); PIN(X); SBAR(); }while(0)
  #define VRD(i) do{ vlo[i]=vtr(vp_+(((i)>>2)*4096+((i)&3)*1024)); vhi[i]=vtr(vp_+(((i)>>2)*4096+((i)&3)*1024+512)); }while(0)
  #define KRD(G,j) do{ if(G){ kload2(kf,kp0+sl_next,j); SBAR(); } }while(0)
  #define STEP(C0,C1,P0,P1,t,GK,GV,GL) do{ SBAR(); \
    const lds_cptr vp_=vp0+sl_prev; \
    VRD(0); SBAR(); float sacc=(P0[0]+P0[1]); \
    GAPA(C0=__builtin_amdgcn_mfma_f32_32x32x16_bf16(kf[0],qr[0],negm,0,0,0), P0[2],P0[3],P0[4],P0[5],     pw0[0]=PKW(P0,0), pw0[1]=PKW(P0,2), pw0); \
    VRD(4); SBAR(); GAPA(C1=__builtin_amdgcn_mfma_f32_32x32x16_bf16(kf[1],qr[0],negm,0,0,0), P0[6],P0[7],P0[8],P0[9],     pw0[2]=PKW(P0,4), pw0[3]=PKW(P0,6), pw0); \
    VRD(1); SBAR(); GAPA(C0=__builtin_amdgcn_mfma_f32_32x32x16_bf16(kf[2],qr[1],C0,0,0,0),   P0[10],P0[11],P0[12],P0[13], pw1[0]=PKW(P0,8), pw1[1]=PKW(P0,10), pw1); \
    VRD(5); SBAR(); GAPA(C1=__builtin_amdgcn_mfma_f32_32x32x16_bf16(kf[3],qr[1],C1,0,0,0),   P0[14],P0[15],P1[0],P1[1],   pw1[2]=PKW(P0,12),pw1[3]=PKW(P0,14), pw1); \
    VRD(2); SBAR(); GAPA(C0=__builtin_amdgcn_mfma_f32_32x32x16_bf16(kf[4],qr[2],C0,0,0,0),   P1[2],P1[3],P1[4],P1[5],     pw2[0]=PKW(P1,0), pw2[1]=PKW(P1,2), pw2); \
    VRD(6); SBAR(); GAPA(C1=__builtin_amdgcn_mfma_f32_32x32x16_bf16(kf[5],qr[2],C1,0,0,0),   P1[6],P1[7],P1[8],P1[9],     pw2[2]=PKW(P1,4), pw2[3]=PKW(P1,6), pw2); \
    VRD(3); SBAR(); GAPA(C0=__builtin_amdgcn_mfma_f32_32x32x16_bf16(kf[6],qr[3],C0,0,0,0),   P1[10],P1[11],P1[12],P1[13], pw3[0]=PKW(P1,8), pw3[1]=PKW(P1,10), pw3); \
    VRD(7); SBAR(); GAPA(C1=__builtin_amdgcn_mfma_f32_32x32x16_bf16(kf[7],qr[3],C1,0,0,0),   P1[14],P1[15],0.f,0.f,       pw3[2]=PKW(P1,12),pw3[3]=PKW(P1,14), pw3); \
    l_reg+=sacc; \
    if(GK){DMA_K((t)+3,sl_cur);} if(GV){DMA_V((t)+1,sl_next);} \
    CMASK(C0,C1,t); \
    { float a=MX3(C0[0],C0[1],C1[0]),b=MX3(C0[2],C0[3],C1[1]); a=MX3(a,C1[2],C1[3]); \
      _Pragma("unroll") for(int r=4;r<16;r+=4){a=MX3(a,C0[r],C0[r+1]);b=MX3(b,C0[r+2],C0[r+3]);a=MX3(a,C1[r],C1[r+1]);b=MX3(b,C1[r+2],C1[r+3]);} \
      float rm=__builtin_fmaxf(a,b); { auto rr=__builtin_amdgcn_permlane32_swap(__float_as_uint(rm),__float_as_uint(rm),false,false); rm=__builtin_fmaxf(__uint_as_float(rr[0]),__uint_as_float(rr[1])); } \
      resc=false; \
      if(__builtin_expect(__any(rm>(float)THRL),0)){ const float dl=__builtin_fmaxf(rm,0.f); mhat+=dl; \
        _Pragma("unroll") for(int r=0;r<16;++r){C0[r]-=dl;C1[r]-=dl;} \
        _Pragma("unroll") for(int r=0;r<16;++r)negm[r]=-mhat; asm volatile("":"+v"(negm)); \
        const float f=__builtin_amdgcn_exp2f(-dl); l_reg*=f; if(hi==0)wsf[r32]=f; resc=true; } } \
    SBAR(); \
    GAPB(o[0]=__builtin_amdgcn_mfma_f32_32x32x16_bf16(PAF(0),VFR(0),o[0],0,0,0), C0,0); \
    GAPB(o[1]=__builtin_amdgcn_mfma_f32_32x32x16_bf16(PAF(0),VFR(4),o[1],0,0,0), C0,4); \
    KRD(GL,0); GAPB(o[0]=__builtin_amdgcn_mfma_f32_32x32x16_bf16(PAF(1),VFR(1),o[0],0,0,0), C0,8); \
    KRD(GL,1); GAPB(o[1]=__builtin_amdgcn_mfma_f32_32x32x16_bf16(PAF(1),VFR(5),o[1],0,0,0), C0,12); \
    KRD(GL,2); GAPB(o[0]=__builtin_amdgcn_mfma_f32_32x32x16_bf16(PAF(2),VFR(2),o[0],0,0,0), C1,0); \
    KRD(GL,3); GAPB(o[1]=__builtin_amdgcn_mfma_f32_32x32x16_bf16(PAF(2),VFR(6),o[1],0,0,0), C1,4); \
    GAPB(o[0]=__builtin_amdgcn_mfma_f32_32x32x16_bf16(PAF(3),VFR(3),o[0],0,0,0), C1,8); \
    GAPB(o[1]=__builtin_amdgcn_mfma_f32_32x32x16_bf16(PAF(3),VFR(7),o[1],0,0,0), C1,12); \
    }while(0)
  int t=1;
  #undef CMASK
  #define CMASK(P0,P1,t) do{}while(0)
  for(;t+5<NT;t+=2){
    STEP(pB0,pB1,pA0,pA1,t,true,true,true);     WAIT_BAR(2); RESC(); ROT();
    STEP(pA0,pA1,pB0,pB1,t+1,true,true,true);   WAIT_BAR(2); RESC(); ROT();
  }
  #undef CMASK
  #define CMASK(P0,P1,t) do{int jb_=(t)-(NT-4); if(jb_>=0)cmask(P0,P1,jb_,qrel,hi);}while(0)
  #define ENDW(tt) do{ if((tt)+3<NT){WAIT_BAR(2);} else if((tt)+2<NT){WAIT_BAR(1);} else {WAIT_BAR(0);} }while(0)
  for(;t+1<NT;t+=2){
    STEP(pB0,pB1,pA0,pA1,t,(t+3<NT),(t+1<NT),(t+1<NT));       ENDW(t);   RESC(); ROT();
    STEP(pA0,pA1,pB0,pB1,t+1,(t+4<NT),(t+2<NT),(t+2<NT));     ENDW(t+1); RESC(); ROT();
  }
  STEP(pB0,pB1,pA0,pA1,NT-1,false,false,false); RESC();
  { float sacc=pB0[0]+pB0[1]; _Pragma("unroll") for(int r=2;r<16;++r)sacc+=pB0[r]; _Pragma("unroll") for(int r=0;r<16;++r)sacc+=pB1[r]; l_reg+=sacc;
    pw0=(u32x4){PKW(pB0,0),PKW(pB0,2),PKW(pB0,4),PKW(pB0,6)};pw1=(u32x4){PKW(pB0,8),PKW(pB0,10),PKW(pB0,12),PKW(pB0,14)};pw2=(u32x4){PKW(pB1,0),PKW(pB1,2),PKW(pB1,4),PKW(pB1,6)};pw3=(u32x4){PKW(pB1,8),PKW(pB1,10),PKW(pB1,12),PKW(pB1,14)};
    SBAR(); pv(o,vb0+sl_cur,PAF(0),PAF(1),PAF(2),PAF(3)); }
  #undef PKW
  #undef PAF
  #undef VFR
  #undef PIN
  #undef MX3
  #undef GAPA
  #undef GAPB
  #undef EX
  #undef VRD
  #undef KRD
  #undef STEP
  #undef ENDW
  {auto rr=__builtin_amdgcn_permlane32_swap(__float_as_uint(l_reg),__float_as_uint(l_reg),false,false);l_reg=__uint_as_float(rr[0])+__uint_as_float(rr[1]);}
  if(hi==0)wsf[32+r32]=l_reg;asm volatile("s_waitcnt lgkmcnt(0)":::"memory");
  float rli[16];
  #pragma unroll
  for(int r=0;r<16;++r)rli[r]=__builtin_amdgcn_rcpf(wsf[32+crow(r,hi)]);
  bf16*Ow=O+(rowbase+q0+wid*QBLK)*DM+ocol;
  { bf16*stg=(bf16*)(shm+LDS_OST)+wid*2048;
    #pragma unroll
    for(int r=0;r<16;++r){const int orow=crow(r,hi);
      #pragma unroll
      for(int d0=0;d0<2;++d0)stg[orow*64+d0*32+r32]=__float2bfloat16(o[d0][r]*rli[r]);}
    asm volatile("s_waitcnt lgkmcnt(0)":::"memory");
    #pragma unroll
    for(int i=0;i<4;++i){const int row=i*8+(lane>>3),ch=lane&7; const u32x4 v=*(const u32x4*)(stg+row*64+ch*8); ATTN_STORE16(Ow+(long)row*DM+ch*8,v);} }
  asm volatile("s_waitcnt lgkmcnt(0)\n\ts_barrier":::"memory");
  #undef DMA_K
  #undef DMA_V
  #undef CMASK
  #undef START
  #undef RESC
  #undef ROT
}
constexpr int ATTN_LDS_BYTES=LDS_BYTES;
#undef SBAR
#undef WAIT_BAR
}

namespace cg = cooperative_groups;
#define LAS __attribute__((address_space(3)))
typedef unsigned short bf16;
typedef unsigned v4u __attribute__((ext_vector_type(4)));
typedef unsigned v2u __attribute__((ext_vector_type(2)));
typedef float f32x4 __attribute__((ext_vector_type(4)));
typedef short bf16x8 __attribute__((ext_vector_type(8)));

constexpr int NWAVES = 8, NTHR = 512;
constexpr int M = 16384, D = 1024, SEQL = 2048, NB = 8, FF = 2816;
constexpr int DIN = 9232;
constexpr float EPS = 1e-6f;
constexpr size_t MiB = 1u << 20;
constexpr size_t WS_G = 1 * MiB, WS_BETA = WS_G + 512 * 1024, WS_GL = 2 * MiB;
constexpr size_t WS_WING = 3 * MiB, WS_WINA = 11 * MiB, WS_WINX = 17 * MiB, WS_WBA = 21 * MiB, WS_WBB = 23 * MiB, WS_WOUT = 25 * MiB;
constexpr size_t WS_WUP = 27 * MiB, WS_WDN = 38 * MiB, WS_XN = 44 * MiB, WS_BIG = 76 * MiB;
constexpr size_t B_GQ = WS_BIG, B_GK = WS_BIG + 32 * MiB, B_GV = WS_BIG + 64 * MiB, B_GZ = WS_BIG + 96 * MiB, B_WB = WS_BIG + 128 * MiB, B_AQK = WS_BIG + 160 * MiB;
constexpr size_t B_Q = WS_BIG, B_K = WS_BIG + 32 * MiB, B_V = WS_BIG + 64 * MiB, B_O1 = WS_BIG + 96 * MiB, B_O2 = WS_BIG + 128 * MiB;
constexpr size_t B_GATES = WS_BIG + 32 * MiB, B_MRG = WS_BIG + 96 * MiB;
constexpr size_t B_U = WS_BIG, B_ACT = WS_BIG + 88 * MiB, B_F = WS_BIG;
constexpr int RING_BYTES = 131072, LDS_BYTES = 147456;

__device__ __forceinline__ unsigned f2bf(float f) { unsigned u = __builtin_bit_cast(unsigned, f); return (u + 0x7fffu + ((u >> 16) & 1u)) >> 16; }
typedef float f32x2_pk __attribute__((ext_vector_type(2))); typedef __bf16 bf16x2_pk __attribute__((ext_vector_type(2)));
__device__ __forceinline__ unsigned pk2(float lo, float hi) { f32x2_pk v = {lo, hi}; bf16x2_pk b = __builtin_convertvector(v, bf16x2_pk); return __builtin_bit_cast(unsigned, b); }
__device__ __forceinline__ float bflo(unsigned w) { return __builtin_bit_cast(float, w << 16); }
__device__ __forceinline__ float bfhi(unsigned w) { return __builtin_bit_cast(float, w & 0xffff0000u); }
__device__ __forceinline__ float bf1(bf16 h) { return __builtin_bit_cast(float, (unsigned)h << 16); }
__device__ __forceinline__ float sigmoidf_(float x) { return __builtin_amdgcn_rcpf(1.f + __expf(-x)); }
__device__ __forceinline__ float siluf_(float x) { return x * __builtin_amdgcn_rcpf(1.f + __expf(-x)); }
__device__ __forceinline__ float wave_sum(float v) {
#pragma unroll
    for (int o = 1; o < 64; o <<= 1) v += __shfl_xor(v, o);
    return v;
}
__device__ __forceinline__ void unpack8(const v4u w, float* f) { f[0] = bflo(w.x); f[1] = bfhi(w.x); f[2] = bflo(w.y); f[3] = bfhi(w.y); f[4] = bflo(w.z); f[5] = bfhi(w.z); f[6] = bflo(w.w); f[7] = bfhi(w.w); }

namespace pg8 {
template <bool ADD> struct EpiGate {
    static constexpr bool PERM = true, AFTER_DRAIN = false;
    bf16_t* O; const bf16_t* gates; int gofs;
    __device__ __forceinline__ void operator()(const f32x4 (&acc)[2][2][4][2], const Unit& u, int wr, int wc, int fr, int fq) const {
        const int row0 = u.pm * BM + wr * 64 + fr, col0 = u.pn * BM + wc * 32 + 8 * fq;
#pragma unroll
        for (int ai = 0; ai < 2; ++ai)
#pragma unroll
            for (int m = 0; m < 4; ++m) { const size_t row = (size_t)(row0 + ai * HALF + m * 16);
#pragma unroll
                for (int bj = 0; bj < 2; ++bj) { const int col = col0 + bj * HALF;
                    const u32x4 gw = *(const u32x4*)(gates + row * 2048 + gofs + col);
                    float g[8]; g[0] = __builtin_bit_cast(float, gw.x << 16); g[1] = __builtin_bit_cast(float, gw.x & 0xffff0000u); g[2] = __builtin_bit_cast(float, gw.y << 16); g[3] = __builtin_bit_cast(float, gw.y & 0xffff0000u);
                    g[4] = __builtin_bit_cast(float, gw.z << 16); g[5] = __builtin_bit_cast(float, gw.z & 0xffff0000u); g[6] = __builtin_bit_cast(float, gw.w << 16); g[7] = __builtin_bit_cast(float, gw.w & 0xffff0000u);
                    float v[8]; const f32x4 a0 = acc[ai][bj][m][0], a1 = acc[ai][bj][m][1];
                    v[0] = a0[0]; v[1] = a0[1]; v[2] = a0[2]; v[3] = a0[3]; v[4] = a1[0]; v[5] = a1[1]; v[6] = a1[2]; v[7] = a1[3];
#pragma unroll
                    for (int e = 0; e < 8; ++e) v[e] = v[e] * __builtin_amdgcn_rcpf(1.f + __expf(-g[e]));
                    bf16_t* op = O + row * 1024 + col;
                    if (ADD) { const u32x4 pw = *(const u32x4*)op;
                        v[0] += __builtin_bit_cast(float, pw.x << 16); v[1] += __builtin_bit_cast(float, pw.x & 0xffff0000u); v[2] += __builtin_bit_cast(float, pw.y << 16); v[3] += __builtin_bit_cast(float, pw.y & 0xffff0000u);
                        v[4] += __builtin_bit_cast(float, pw.z << 16); v[5] += __builtin_bit_cast(float, pw.z & 0xffff0000u); v[6] += __builtin_bit_cast(float, pw.w << 16); v[7] += __builtin_bit_cast(float, pw.w & 0xffff0000u); }
                    u32x4 w; w.x = cvt_pk_bf16(v[0], v[1]); w.y = cvt_pk_bf16(v[2], v[3]); w.z = cvt_pk_bf16(v[4], v[5]); w.w = cvt_pk_bf16(v[6], v[7]);
                    *(u32x4*)op = w; } }
    }
};
struct EpiF32 {
    static constexpr bool PERM = false, AFTER_DRAIN = false;
    float* O; int ldc;
    __device__ __forceinline__ void operator()(const f32x4 (&acc)[2][2][4][2], const Unit& u, int wr, int wc, int fr, int fq) const {
        const int row0 = u.pm * BM + wr * 64 + fr, col0 = u.pn * BM + wc * 32 + 4 * fq;
#pragma unroll
        for (int ai = 0; ai < 2; ++ai)
#pragma unroll
            for (int m = 0; m < 4; ++m) { float* rowp = O + (size_t)(row0 + ai * HALF + m * 16) * ldc + col0;
#pragma unroll
                for (int bj = 0; bj < 2; ++bj)
#pragma unroll
                    for (int n = 0; n < 2; ++n) *(f32x4*)(rowp + bj * HALF + n * 16) = acc[ai][bj][m][n]; }
    }
};

#define ROR1(v) __builtin_bit_cast(float, __builtin_amdgcn_mov_dpp(__builtin_bit_cast(int, (v)), 0x121, 0xf, 0xf, true))
#define ROR2(v) __builtin_bit_cast(float, __builtin_amdgcn_mov_dpp(__builtin_bit_cast(int, (v)), 0x122, 0xf, 0xf, true))
struct EpiConvAct {
    static constexpr bool PERM = true, AFTER_DRAIN = false;
    bf16_t* ACT; const float* cw; const float* cb; __attribute__((address_space(3))) unsigned char* xb;
    __device__ __forceinline__ void operator()(const f32x4 (&acc)[2][2][4][2], const Unit& u, int wr, int wc, int fr, int fq) const {
        typedef __attribute__((address_space(3))) f32x4 lf4;
        const int wave = wr * 4 + wc;
        lf4* XB = (lf4*)xb;
        if (fr >= 14) {
#pragma unroll
            for (int ai = 0; ai < 2; ++ai)
#pragma unroll
                for (int bj = 0; bj < 2; ++bj)
#pragma unroll
                    for (int n = 0; n < 2; ++n) XB[((((wave * 2 + ai) * 2 + (fr - 14)) * 4 + fq) * 2 + bj) * 2 + n] = acc[ai][bj][3][n];
        }
        asm volatile("s_waitcnt lgkmcnt(0)\n\ts_barrier" ::: "memory");
        const int f0 = u.pn * 128 + wc * 32 + 8 * fq;
        const int growb = u.pm * 254 - 2 + wr * 64 + fr;
        const int lane_ = fq * 16 + fr, src1_ = (lane_ & 48) | ((fr + 15) & 15), src2_ = (lane_ & 48) | ((fr + 14) & 15);
#pragma unroll
        for (int n = 0; n < 2; ++n) {
            const int fc = f0 + 4 * n;
            f32x4 wg[3], wu[3];
#pragma unroll
            for (int j = 0; j < 3; ++j) { wg[j] = *(const f32x4*)(cw + j * 5632 + fc); wu[j] = *(const f32x4*)(cw + j * 5632 + 2816 + fc); }
            const f32x4 bg = *(const f32x4*)(cb + fc), bu = *(const f32x4*)(cb + 2816 + fc);
#pragma unroll
            for (int ai = 0; ai < 2; ++ai) {
                f32x4 b14[2], b15[2];
                { int pw = wave, pa = ai; if (wr == 1) pw = wave - 4; else { pw = wave + 4; pa = 0; }
                  const bool has = (wr == 1) || (ai == 1);
#pragma unroll
                  for (int bj = 0; bj < 2; ++bj) { if (has) { b14[bj] = XB[((((pw * 2 + pa) * 2 + 0) * 4 + fq) * 2 + bj) * 2 + n]; b15[bj] = XB[((((pw * 2 + pa) * 2 + 1) * 4 + fq) * 2 + bj) * 2 + n]; }
                      else { b14[bj] = (f32x4){0.f, 0.f, 0.f, 0.f}; b15[bj] = b14[bj]; } } }
#pragma unroll
                for (int m = 0; m < 4; ++m) {
                    const int lr = ai * 128 + wr * 64 + m * 16 + fr; const int grow = growb + ai * 128 + m * 16; const int tt = grow & 2047;
                    const bool edge = __builtin_expect(__any(tt <= 1), 0);
                    float cvv[2][4], fx1[2][4], fx2[2][4];
#pragma unroll
                    for (int bj = 0; bj < 2; ++bj) {
                        const f32x4 xq = acc[ai][bj][m][n];
                        const float xs[4] = {xq.x, xq.y, xq.z, xq.w};
                        float ps[4] = {0.f, 0.f, 0.f, 0.f};
                        if (m > 0) { const f32x4 pq = acc[ai][bj][m > 0 ? m - 1 : 0][n]; ps[0] = pq.x; ps[1] = pq.y; ps[2] = pq.z; ps[3] = pq.w; }
                        const float b4[4] = {b14[bj].x, b14[bj].y, b14[bj].z, b14[bj].w}, b5[4] = {b15[bj].x, b15[bj].y, b15[bj].z, b15[bj].w};
                        const f32x4 W0 = bj ? wu[0] : wg[0], W1 = bj ? wu[1] : wg[1], W2 = bj ? wu[2] : wg[2], BB = bj ? bu : bg;
                        const float w0s[4] = {W0.x, W0.y, W0.z, W0.w}, w1s[4] = {W1.x, W1.y, W1.z, W1.w}, w2s[4] = {W2.x, W2.y, W2.z, W2.w}, bbs[4] = {BB.x, BB.y, BB.z, BB.w};
#pragma unroll
                        for (int e = 0; e < 4; ++e) {
                            float q1, q2;
                            if (m == 0) { q1 = b5[e]; q2 = (fr == 1) ? b5[e] : b4[e]; }
                            else { q1 = ROR1(ps[e]); q2 = ROR2(ps[e]); }
                            float a1 = __builtin_bit_cast(float, __builtin_amdgcn_update_dpp(__builtin_bit_cast(int, q1), __builtin_bit_cast(int, xs[e]), 0x111, 0xf, 0xf, false));
                            float a2 = __builtin_bit_cast(float, __builtin_amdgcn_update_dpp(__builtin_bit_cast(int, q2), __builtin_bit_cast(int, xs[e]), 0x112, 0xf, 0xf, false));
                            cvv[bj][e] = fmaf(w0s[e], a2, fmaf(w1s[e], a1, fmaf(w2s[e], xs[e], bbs[e])));
                            fx1[bj][e] = w1s[e] * a1; fx2[bj][e] = w0s[e] * a2;
                        }
                    }
                    if (edge) { asm volatile("" ::: "memory");
#pragma unroll
                        for (int bj = 0; bj < 2; ++bj)
#pragma unroll
                            for (int e = 0; e < 4; ++e) { if (tt == 0) cvv[bj][e] -= fx1[bj][e]; if (tt <= 1) cvv[bj][e] -= fx2[bj][e]; } }
                    if (lr >= 2 && grow < 16384) {
                        float o[4];
#pragma unroll
                        for (int e = 0; e < 4; ++e) o[e] = cvv[0][e] * __builtin_amdgcn_rcpf(1.f + __expf(-cvv[0][e])) * cvv[1][e];
                        typedef unsigned u32x2 __attribute__((ext_vector_type(2)));
                        u32x2 w; w.x = cvt_pk_bf16(o[0], o[1]); w.y = cvt_pk_bf16(o[2], o[3]);
                        *(u32x2*)(ACT + (size_t)grow * 2816 + fc) = w;
                    }
                }
            }
        }
    }
};

struct EpiBf16Wait {
    static constexpr bool PERM = true, AFTER_DRAIN = false;
    EpiBf16<0> inner; const unsigned* prog;
    __device__ __forceinline__ void operator()(const f32x4 (&acc)[2][2][4][2], const Unit& u, int wr, int wc, int fr, int fq) const {
        const int b = u.pm >> 3; const unsigned need = 4u * (unsigned)(u.pm & 7) + 4u;
        for (int h = 0; h < 8; ++h) { unsigned spins = 0;
            while (__hip_atomic_load(prog + (b * 8 + h) * 16, __ATOMIC_RELAXED, __HIP_MEMORY_SCOPE_AGENT) < need) { __builtin_amdgcn_s_sleep(8); if (++spins > (1u << 22)) break; } }
        asm volatile("" ::: "memory");
        inner(acc, u, wr, wc, fr, fq);
    }
};
struct ChunkOrder {
    int G, c;
    __device__ __forceinline__ bool next(int i, Unit& u) const { const int L = i * G + c; if (L >= 512) return false; const int slot = L >> 6, within = L & 63; u.pm = (within >> 3) * 8 + slot; u.pn = within & 7; return true; }
    __device__ __forceinline__ void a_ready(const Unit&) const {}
    __device__ __forceinline__ void done(const Unit&) const {}
};
}

#define RLX_AGENT __ATOMIC_RELAXED, __HIP_MEMORY_SCOPE_AGENT
#define XB_TMO      128
#define XB_XCNT(j)  (256  + 64 * (j))
#define XB_XSUB(j)  (1280 + 64 * (j))
#define XB_XGEN(j)  (2304 + 64 * (j))
#define XB_TOP      3328
#define XB_TOPGEN   3392
#define XCD_BAR_WORDS 3456
#define XB_SPIN_CAP (1u << 18)

__device__ __forceinline__ unsigned xb_ld(unsigned* p)              { return __hip_atomic_load(p, __ATOMIC_RELAXED, __HIP_MEMORY_SCOPE_AGENT); }
__device__ __forceinline__ unsigned xb_add(unsigned* p, unsigned v) { return __hip_atomic_fetch_add(p, v, __ATOMIC_RELAXED, __HIP_MEMORY_SCOPE_AGENT); }
__device__ __forceinline__ unsigned xb_xcc_id() { return (unsigned)__builtin_amdgcn_s_getreg((3 << 11) | 20) & 0xFu; }
#define XB_SPIN(cond, bar) do { unsigned _sp = 0; while (cond) { __builtin_amdgcn_s_sleep(1); \
    if ((++_sp & 255u) == 0u) { if (xb_ld(&(bar)[XB_TMO])) break; if (_sp > XB_SPIN_CAP) { atomicAdd(&(bar)[XB_TMO], 1u); break; } } } } while (0)

struct XcdBarrier {
    unsigned* bar; unsigned x;
    volatile LAS unsigned* st;
};

__device__ __forceinline__ XcdBarrier xcd_barrier_post(unsigned* bar, volatile LAS unsigned* st) {
    XcdBarrier b; b.bar = bar; b.x = xb_xcc_id(); b.st = st;
    if (threadIdx.x == 0) (void)xb_add(&bar[XB_XCNT(b.x)], 1u);
    return b;
}
__device__ __forceinline__ void xcd_barrier_complete(unsigned* bar, unsigned x, unsigned& nloc, unsigned& nx) {
    const unsigned G = gridDim.x * gridDim.y * gridDim.z;
    unsigned sum, cnt, mine, sp = 0u;
    for (;;) {
        sum = 0u; cnt = 0u; mine = 0u;
#pragma unroll
        for (unsigned j = 0; j < 16; ++j) { const unsigned c = xb_ld(&bar[XB_XCNT(j)]); sum += c; cnt += (c > 0u) ? 1u : 0u; mine = (j == x) ? c : mine; }
        if (sum == G) break;
        __builtin_amdgcn_s_sleep(1);
        if ((++sp & 255u) == 0u) { if (xb_ld(&bar[XB_TMO])) break; if (sp > XB_SPIN_CAP) { atomicAdd(&bar[XB_TMO], 1u); break; } }
    }
    nloc = mine > 0u ? mine : 1u; nx = cnt > 0u ? cnt : 1u;
}

__device__ __forceinline__ void xcd_barrier(const XcdBarrier& b) {
    asm volatile("s_waitcnt vmcnt(0)" ::: "memory");
    __syncthreads();
    if (threadIdx.x == 0) {
        unsigned* bar = b.bar;
        __builtin_amdgcn_s_waitcnt(0);
        unsigned nloc = b.st[0], nx = b.st[1];
        if (nloc == 0u) { xcd_barrier_complete(bar, b.x, nloc, nx); b.st[0] = nloc; b.st[1] = nx; }
        const unsigned old = xb_add(&bar[XB_XSUB(b.x)], 1u);
        const unsigned gen = old / nloc;
        if (old + 1u == (gen + 1u) * nloc) {
            __builtin_amdgcn_fence(__ATOMIC_RELEASE, "agent");
            asm volatile("s_waitcnt vmcnt(0)" ::: "memory");
            const unsigned og = xb_add(&bar[XB_TOP], 1u);
            const unsigned tg = og / nx;
            if (og + 1u == (tg + 1u) * nx) xb_add(&bar[XB_TOPGEN], 1u);
            else XB_SPIN(xb_ld(&bar[XB_TOPGEN]) == tg, bar);
            __builtin_amdgcn_fence(__ATOMIC_ACQUIRE, "agent");
            xb_add(&bar[XB_XGEN(b.x)], 1u);
            asm volatile("s_waitcnt vmcnt(0)" ::: "memory");
        } else {
            XB_SPIN(xb_ld(&bar[XB_XGEN(b.x)]) == gen, bar);
            __builtin_amdgcn_fence(__ATOMIC_ACQUIRE, "agent");
            asm volatile("s_waitcnt vmcnt(0)" ::: "memory");
        }
    }
    __syncthreads();
}

struct Args { const float* in[22]; float* out; unsigned char* ws; int ph_lo, ph_hi; };

#define LDS_BAR() asm volatile("s_waitcnt lgkmcnt(0)\n\ts_barrier" ::: "memory")
struct Ctx {
    LAS unsigned char* lds; unsigned char* ws; int tid, lane, wave, G, bid;
};

__device__ __forceinline__ void transpose_item(const float* W, int ldw, int src_n0, int k0, int K, bf16* WT, int dst_n0, LAS float* scr, int lane) {
    float tv[32];
#pragma unroll
    for (int i = 0; i < 32; ++i) { const int kk = 2 * i + (lane >> 5); tv[i] = W[(size_t)(k0 + kk) * ldw + src_n0 + (lane & 31)]; }
#pragma unroll
    for (int i = 0; i < 32; ++i) { const int kk = 2 * i + (lane >> 5); scr[kk * 33 + (lane & 31)] = tv[i]; }
    asm volatile("s_waitcnt lgkmcnt(0)" ::: "memory");
    const int c = lane & 7;
#pragma unroll
    for (int j = 0; j < 4; ++j) { const int n = (lane >> 3) + 8 * j; const LAS float* s = scr + (8 * c) * 33 + n;
        v4u o; o.x = pk2(s[0 * 33], s[1 * 33]); o.y = pk2(s[2 * 33], s[3 * 33]); o.z = pk2(s[4 * 33], s[5 * 33]); o.w = pk2(s[6 * 33], s[7 * 33]);
        *(v4u*)(WT + (size_t)(dst_n0 + n) * K + k0 + 8 * c) = o; }
    asm volatile("s_waitcnt lgkmcnt(0)" ::: "memory");
}
__device__ __forceinline__ void p0_prologue(const Ctx& C, const Args& a) {
    unsigned char* ws = C.ws;
    LAS float* scr = (LAS float*)(C.lds + C.wave * 16384);
    const int gw = C.bid * NWAVES + C.wave, NGW = C.G * NWAVES;
    const float* w_in = a.in[2];
    constexpr int I_G = 16 * 128, I_A = 16 * 96;
    constexpr int NITEMS = I_G + I_A;
    for (int it = gw; it < NITEMS; it += NGW) {
        int r = it;
        if (r < I_G) { const int kb = r / 128, nb = r % 128; transpose_item(w_in, DIN, 32 * nb, 64 * kb, 1024, (bf16*)(ws + WS_WING), 32 * nb, scr, C.lane); continue; } r -= I_G;
        { const int kb = r / 96, nb = r % 96; transpose_item(w_in, DIN, 4112 + 32 * nb, 64 * kb, 1024, (bf16*)(ws + WS_WINA), 32 * nb, scr, C.lane); }
    }
    __syncthreads();
    LAS float* WabT = (LAS float*)C.lds;
    for (int k = C.tid; k < 1024; k += NTHR) {
        const f32x4* src = (const f32x4*)(w_in + (size_t)k * DIN + 4096);
#pragma unroll
        for (int q = 0; q < 4; ++q) { const f32x4 v = src[q]; WabT[(4 * q + 0) * 1024 + k] = v.x; WabT[(4 * q + 1) * 1024 + k] = v.y; WabT[(4 * q + 2) * 1024 + k] = v.z; WabT[(4 * q + 3) * 1024 + k] = v.w; }
    }
    __syncthreads();
    const float* x = a.in[0]; const float* gpre = a.in[1];
    bf16* XN = (bf16*)(ws + WS_XN); float* GA = (float*)(ws + WS_G); float* BE = (float*)(ws + WS_BETA);
    f32x4 gn[4];
#pragma unroll
    for (int j = 0; j < 4; ++j) gn[j] = ((const f32x4*)gpre)[C.lane + 64 * j];
    const int hsel = C.lane & 7;
    const float alog = a.in[4][hsel], dtb = a.in[5][hsel];
    for (int mp = gw; mp < M / 2; mp += NGW) {
        f32x4 v0[4], v1[4]; float s0 = 0.f, s1 = 0.f;
        { const f32x4* xr = (const f32x4*)(x + (size_t)(2 * mp) * D) + C.lane;
#pragma unroll
          for (int j = 0; j < 4; ++j) { v0[j] = xr[64 * j]; v1[j] = xr[64 * j + 256]; s0 += (v0[j].x * v0[j].x + v0[j].y * v0[j].y) + (v0[j].z * v0[j].z + v0[j].w * v0[j].w); s1 += (v1[j].x * v1[j].x + v1[j].y * v1[j].y) + (v1[j].z * v1[j].z + v1[j].w * v1[j].w); } }
#pragma unroll
        for (int o = 1; o < 64; o <<= 1) { s0 += __shfl_xor(s0, o); s1 += __shfl_xor(s1, o); }
        const float r0 = __builtin_amdgcn_rsqf(s0 * (1.f / D) + EPS), r1 = __builtin_amdgcn_rsqf(s1 * (1.f / D) + EPS);
        unsigned long long* o8 = (unsigned long long*)(XN + (size_t)(2 * mp) * D) + C.lane;
#pragma unroll
        for (int j = 0; j < 4; ++j) { v0[j] = v0[j] * r0 * gn[j]; v1[j] = v1[j] * r1 * gn[j];
            o8[64 * j] = (unsigned long long)pk2(v0[j].x, v0[j].y) | ((unsigned long long)pk2(v0[j].z, v0[j].w) << 32);
            o8[64 * j + 256] = (unsigned long long)pk2(v1[j].x, v1[j].y) | ((unsigned long long)pk2(v1[j].z, v1[j].w) << 32); }
        float mine0 = 0.f, mine1 = 0.f;
#pragma unroll 2
        for (int c = 0; c < 16; ++c) { float p0 = 0.f, p1 = 0.f;
#pragma unroll
            for (int j = 0; j < 4; ++j) { const f32x4 w = *(const LAS f32x4*)(WabT + c * 1024 + 4 * C.lane + 256 * j);
                p0 += (v0[j].x * w.x + v0[j].y * w.y) + (v0[j].z * w.z + v0[j].w * w.w); p1 += (v1[j].x * w.x + v1[j].y * w.y) + (v1[j].z * w.z + v1[j].w * w.w); }
#pragma unroll
            for (int o = 1; o < 64; o <<= 1) { p0 += __shfl_xor(p0, o); p1 += __shfl_xor(p1, o); }
            mine0 = (C.lane == c) ? p0 : mine0; mine1 = (C.lane == c) ? p1 : mine1; }
#pragma unroll
        for (int rr = 0; rr < 2; ++rr) { const float mine = rr ? mine1 : mine0; const size_t m = (size_t)(2 * mp + rr);
            if (C.lane < 8) { const float z = mine + dtb; const float sp = fmaxf(z, 0.f) + log1pf(__expf(-fabsf(z))); GA[m * 8 + C.lane] = -__expf(alog) * sp; }
            else if (C.lane < 16) BE[m * 8 + (C.lane - 8)] = 1.f / (1.f + __expf(-mine)); }
    }
}

__device__ __forceinline__ void late_transposes(const Ctx& C, const Args& a, int idx, int cnt) {
    unsigned char* ws = C.ws;
    LAS float* scr = (LAS float*)(C.lds + C.wave * 16384);
    const int gw = idx * NWAVES + C.wave, NGW = cnt * NWAVES;
    const float* w_in = a.in[2];
    constexpr int I_X = 16 * 64, I_S = 16 * 32, I_UP = 16 * 176, I_DN = 44 * 32;
    constexpr int NITEMS = I_X + 3 * I_S + I_UP + I_DN;
    for (int it = gw; it < NITEMS; it += NGW) {
        int r = it;
        if (r < I_X) { const int kb = r / 64, nb = r % 64; transpose_item(w_in, DIN, 7184 + 32 * nb, 64 * kb, 1024, (bf16*)(ws + WS_WINX), 32 * nb, scr, C.lane); continue; } r -= I_X;
        if (r < I_S) { const int kb = r / 32, nb = r % 32; transpose_item(a.in[12], 1024, 32 * nb, 64 * kb, 1024, (bf16*)(ws + WS_WBA), 32 * nb, scr, C.lane); continue; } r -= I_S;
        if (r < I_S) { const int kb = r / 32, nb = r % 32; transpose_item(a.in[13], 1024, 32 * nb, 64 * kb, 1024, (bf16*)(ws + WS_WBB), 32 * nb, scr, C.lane); continue; } r -= I_S;
        if (r < I_S) { const int kb = r / 32, nb = r % 32; transpose_item(a.in[14], 1024, 32 * nb, 64 * kb, 1024, (bf16*)(ws + WS_WOUT), 32 * nb, scr, C.lane); continue; } r -= I_S;
        if (r < I_UP) { const int kb = r / 176, nb = r % 176; const int dn0 = 32 * nb, tile = dn0 >> 8, within = dn0 & 255;
            const int src = within < 128 ? tile * 128 + within : FF + tile * 128 + (within - 128);
            transpose_item(a.in[17], 2 * FF, src, 64 * kb, 1024, (bf16*)(ws + WS_WUP), dn0, scr, C.lane); continue; } r -= I_UP;
        { const int kb = r / 32, nb = r % 32; transpose_item(a.in[20], 1024, 32 * nb, 64 * kb, FF, (bf16*)(ws + WS_WDN), 32 * nb, scr, C.lane); }
    }
    __syncthreads();
}

constexpr int GL_KN = 0, GL_QN = 17408, GL_KD = 34816, GL_RHS = 52224  , GL_AF = 118784  , GL_AQ = 136192  ;
constexpr int GL_TI = GL_KN  , GL_GC = 145408  ;
constexpr int GL_HALO = 145920  , GL_SEGH = 150528  ;
constexpr int LDS_TOTAL = 160 * 1024;
constexpr int GL_AFT = 152832;
static_assert(GL_SEGH + 9216 <= LDS_TOTAL, "lds");

__device__ __forceinline__ void gdn_halo_preload(const Ctx& C) {
    const bf16* GQ = (const bf16*)(C.ws + B_GQ);
    int s = 0;
    for (int seg = C.bid; seg < 256; seg += C.G, ++s) {
        const int b = seg >> 5, h = (seg >> 2) & 7, qt = seg & 3, c0 = qt * 8;
        LAS v4u* dst = (LAS v4u*)(C.lds + GL_SEGH + s * 2304);
        if (C.tid < 144) {
            const int rr = C.tid / 48, rem = C.tid % 48, X = rem / 16, ch = rem % 16;
            v4u v = {0u, 0u, 0u, 0u};
            if (c0 > 0) v = *(const v4u*)(GQ + (size_t)X * (16 * MiB) + (size_t)(b * SEQL + c0 * 64 - 3 + rr) * 1024 + h * 128 + ch * 8);
            dst[rr * 48 + X * 16 + ch] = v;
        }
    }
}

__device__ __forceinline__ void gdn_local_task(const Ctx& C, const Args& a, int b, int h, int c, const LAS unsigned char* halo_in, LAS unsigned char* halo_out, bool dry) {
    int tid_ = C.tid; asm volatile("" : "+v"(tid_)); const int tid = tid_, lane = tid & 63, wave = C.wave;
    const int r = tid >> 3, cgp = tid & 7;
    const size_t row0 = (size_t)b * SEQL + (size_t)c * 64;
    bf16* GQ = (bf16*)(C.ws + B_GQ); bf16* GK = (bf16*)(C.ws + B_GK); bf16* GV = (bf16*)(C.ws + B_GV);
    bf16* WB = (bf16*)(C.ws + B_WB); bf16* AQK = (bf16*)(C.ws + B_AQK);
    const float* GA = (const float*)(C.ws + WS_G); const float* BE = (const float*)(C.ws + WS_BETA); float* GLs = (float*)(C.ws + WS_GL);
    const float* convw = a.in[3];
    LAS unsigned char* lds = C.lds;
    float gcv, bev;
    { float g = GA[(row0 + lane) * 8 + h]; bev = BE[(row0 + lane) * 8 + h];
#pragma unroll
      for (int o = 1; o < 64; o <<= 1) { const float t = __shfl_up(g, o); if (lane >= o) g += t; }
      gcv = g; }
    const float gc_r = __shfl(gcv, r), be_r = __shfl(bev, r), gl = __shfl(gcv, 63);
    if (wave == 0) { ((LAS float*)(lds + GL_GC))[lane] = gcv; ((LAS float*)(lds + GL_GC))[64 + lane] = bev; if (lane == 63 && !dry) GLs[(b * 8 + h) * 32 + c] = __expf(gcv); }
    float y[3][16];
#pragma unroll
    for (int X = 0; X < 3; ++X) {
        const bf16* src = GQ + (size_t)X * (16 * MiB);
        v4u raw[4][2];
#pragma unroll
        for (int jj = 0; jj < 4; ++jj) { const int rr = r - 3 + jj;
            if (rr >= 0) { const v4u* p = (const v4u*)(src + (row0 + rr) * 1024 + h * 128 + cgp * 16); raw[jj][0] = p[0]; raw[jj][1] = p[1]; }
            else { const LAS v4u* p = (const LAS v4u*)(halo_in) + (3 + rr) * 48 + X * 16 + cgp * 2; raw[jj][0] = p[0]; raw[jj][1] = p[1]; } }
        if (r >= 61) { LAS v4u* p = (LAS v4u*)(halo_out) + (r - 61) * 48 + X * 16 + cgp * 2; p[0] = raw[3][0]; p[1] = raw[3][1]; }
        const float* wp = convw + X * 1024 + h * 128 + cgp * 16;
#pragma unroll
        for (int e = 0; e < 16; ++e) y[X][e] = 0.f;
#pragma unroll
        for (int jj = 0; jj < 4; ++jj) { float f[16]; unpack8(raw[jj][0], f); unpack8(raw[jj][1], f + 8);
#pragma unroll
            for (int q4 = 0; q4 < 4; ++q4) { const f32x4 w = *(const f32x4*)(wp + jj * 3072 + q4 * 4);
                y[X][4 * q4 + 0] += w.x * f[4 * q4 + 0]; y[X][4 * q4 + 1] += w.y * f[4 * q4 + 1]; y[X][4 * q4 + 2] += w.z * f[4 * q4 + 2]; y[X][4 * q4 + 3] += w.w * f[4 * q4 + 3]; } }
#pragma unroll
        for (int e = 0; e < 16; ++e) y[X][e] = siluf_(y[X][e]);
        if (X < 2) { float ss = 0.f;
#pragma unroll
            for (int e = 0; e < 16; ++e) ss += y[X][e] * y[X][e];
            ss += __shfl_xor(ss, 1); ss += __shfl_xor(ss, 2); ss += __shfl_xor(ss, 4);
            const float sc = (1.f / sqrtf(ss + EPS)) * (X == 0 ? 0.08838834764831845f : 1.f);
#pragma unroll
            for (int e = 0; e < 16; ++e) y[X][e] *= sc; }
    }
    const float eg = __expf(gc_r), ekd = __expf(gl - gc_r);
    { LAS unsigned* kn = (LAS unsigned*)(lds + GL_KN + r * 272 + cgp * 32); LAS unsigned* qn = (LAS unsigned*)(lds + GL_QN + r * 272 + cgp * 32); LAS unsigned* kd = (LAS unsigned*)(lds + GL_KD + r * 272 + cgp * 32);
      LAS float* rk = (LAS float*)(lds + GL_RHS) + r * 260 + cgp * 16; LAS float* rv = rk + 128;
#pragma unroll
      for (int e = 0; e < 8; ++e) { qn[e] = pk2(y[0][2 * e], y[0][2 * e + 1]); kn[e] = pk2(y[1][2 * e], y[1][2 * e + 1]); kd[e] = pk2(y[1][2 * e] * ekd, y[1][2 * e + 1] * ekd); }
      const float kb = be_r * eg;
#pragma unroll
      for (int e = 0; e < 16; ++e) { rk[e] = y[1][e] * kb; rv[e] = y[2][e] * be_r; } }
    LDS_BAR();
    {
      v4u o0, o1; o0.x = pk2(y[0][0] * eg, y[0][1] * eg); o0.y = pk2(y[0][2] * eg, y[0][3] * eg); o0.z = pk2(y[0][4] * eg, y[0][5] * eg); o0.w = pk2(y[0][6] * eg, y[0][7] * eg);
      o1.x = pk2(y[0][8] * eg, y[0][9] * eg); o1.y = pk2(y[0][10] * eg, y[0][11] * eg); o1.z = pk2(y[0][12] * eg, y[0][13] * eg); o1.w = pk2(y[0][14] * eg, y[0][15] * eg);
      v4u* p = (v4u*)(GQ + (row0 + r) * 1024 + h * 128 + cgp * 16); if (!dry) { p[0] = o0; p[1] = o1; } }
    const int fr = lane & 15, fq = lane >> 4;
    { const int ti = wave >> 1;
      const LAS float* gcs = (const LAS float*)(lds + GL_GC);
#pragma unroll
      for (int t2 = 0; t2 < 2; ++t2) { const int tj = (wave & 1) * 2 + t2;
          f32x4 kk = {0.f, 0.f, 0.f, 0.f}, qk = {0.f, 0.f, 0.f, 0.f};
          if (tj <= ti) {
#pragma unroll
              for (int ks = 0; ks < 4; ++ks) {
                  const bf16x8 ak = *(const LAS bf16x8*)(lds + GL_KN + (ti * 16 + fr) * 272 + ks * 64 + fq * 16);
                  const bf16x8 aq = *(const LAS bf16x8*)(lds + GL_QN + (ti * 16 + fr) * 272 + ks * 64 + fq * 16);
                  const bf16x8 bk = *(const LAS bf16x8*)(lds + GL_KN + (tj * 16 + fr) * 272 + ks * 64 + fq * 16);
                  kk = __builtin_amdgcn_mfma_f32_16x16x32_bf16(ak, bk, kk, 0, 0, 0);
                  qk = __builtin_amdgcn_mfma_f32_16x16x32_bf16(aq, bk, qk, 0, 0, 0);
              }
          }
          const int j = tj * 16 + fr; const float gcj = gcs[j];
#pragma unroll
          for (int rg = 0; rg < 4; ++rg) { const int i = ti * 16 + 4 * fq + rg; const float gci = gcs[i], bi = gcs[64 + i];
              const float dec = (i >= j) ? __expf(gci - gcj) : 0.f;
              const float av = (i > j) ? bi * dec * kk[rg] : 0.f;
              ((LAS float*)(lds + GL_AF))[i * 68 + j] = av;
              if (ti == tj) ((LAS float*)(lds + GL_AFT))[(ti * 16 + fr) * 20 + 4 * fq + rg] = av;
              ((LAS bf16*)(lds + GL_AQ))[i * 72 + j] = (bf16)f2bf((i >= j) ? dec * qk[rg] : 0.f); }
      } }
    LDS_BAR();
    if (wave < 4) { const int I = wave, rr = lane & 15; const LAS float* At = (const LAS float*)(lds + GL_AFT) + (16 * I) * 20;
        float t[16];
#pragma unroll
        for (int cc = 15; cc >= 0; --cc) { float s = 0.f; float acol[16];
#pragma unroll
            for (int q4 = 0; q4 < 4; ++q4) { const f32x4 v = *(const LAS f32x4*)(At + cc * 20 + 4 * q4); acol[4 * q4] = v.x; acol[4 * q4 + 1] = v.y; acol[4 * q4 + 2] = v.z; acol[4 * q4 + 3] = v.w; }
#pragma unroll
            for (int k = cc + 1; k < 16; ++k) s += t[k] * acol[k];
            t[cc] = (cc == rr) ? 1.f : ((cc < rr) ? -s : 0.f); }
        if (lane < 16) { LAS float* To = (LAS float*)(lds + GL_TI) + (I * 16 + rr) * 20;
#pragma unroll
            for (int q4 = 0; q4 < 4; ++q4) *(LAS f32x4*)(To + 4 * q4) = (f32x4){t[4 * q4], t[4 * q4 + 1], t[4 * q4 + 2], t[4 * q4 + 3]}; } }
    LDS_BAR();
    {
        f32x4 tinv[4];
#pragma unroll
        for (int I = 0; I < 4; ++I) tinv[I] = *(const LAS f32x4*)((const LAS float*)(lds + GL_TI) + (I * 16 + fr) * 20 + 4 * fq);
        LAS float* R0 = (LAS float*)(lds + GL_RHS) + (wave * 2) * 16 + fr; LAS float* R1 = R0 + 16;
        f32x4 Xa[4], Xb[4];
#pragma unroll
        for (int I = 0; I < 4; ++I) { f32x4 acca, accb;
#pragma unroll
            for (int rg = 0; rg < 4; ++rg) { acca[rg] = R0[(16 * I + 4 * fq + rg) * 260]; accb[rg] = R1[(16 * I + 4 * fq + rg) * 260]; }
#pragma unroll
            for (int J = 0; J < 4; ++J) if (J < I) { const f32x4 af = *(const LAS f32x4*)((const LAS float*)(lds + GL_AF) + (16 * I + fr) * 68 + 16 * J + 4 * fq);
#pragma unroll
                for (int s = 0; s < 4; ++s) { acca = __builtin_amdgcn_mfma_f32_16x16x4f32(-af[s], Xa[J][s], acca, 0, 0, 0); accb = __builtin_amdgcn_mfma_f32_16x16x4f32(-af[s], Xb[J][s], accb, 0, 0, 0); } }
            f32x4 xa = {0.f, 0.f, 0.f, 0.f}, xb = {0.f, 0.f, 0.f, 0.f};
#pragma unroll
            for (int s = 0; s < 4; ++s) { xa = __builtin_amdgcn_mfma_f32_16x16x4f32(tinv[I][s], acca[s], xa, 0, 0, 0); xb = __builtin_amdgcn_mfma_f32_16x16x4f32(tinv[I][s], accb[s], xb, 0, 0, 0); }
            Xa[I] = xa; Xb[I] = xb; }
#pragma unroll
        for (int I = 0; I < 4; ++I)
#pragma unroll
            for (int rg = 0; rg < 4; ++rg) { R0[(16 * I + 4 * fq + rg) * 260] = Xa[I][rg]; R1[(16 * I + 4 * fq + rg) * 260] = Xb[I][rg]; }
    }
    LDS_BAR();
    { const LAS float* X = (const LAS float*)(lds + GL_RHS) + r * 260 + cgp * 16;
      v4u o0, o1; o0.x = pk2(X[0], X[1]); o0.y = pk2(X[2], X[3]); o0.z = pk2(X[4], X[5]); o0.w = pk2(X[6], X[7]); o1.x = pk2(X[8], X[9]); o1.y = pk2(X[10], X[11]); o1.z = pk2(X[12], X[13]); o1.w = pk2(X[14], X[15]);
      v4u* p = (v4u*)(WB + (row0 + r) * 1024 + h * 128 + cgp * 16); if (!dry) { p[0] = o0; p[1] = o1; } }
    { const int e = tid & 127, jg = tid >> 7;
      const LAS float* Xu = (const LAS float*)(lds + GL_RHS) + (jg * 16) * 260 + 128 + e;
      const LAS bf16* Kd = (const LAS bf16*)(lds + GL_KD) + (jg * 16) * 136 + e;
      unsigned uo[8], ko[8];
#pragma unroll
      for (int jj = 0; jj < 8; ++jj) { uo[jj] = pk2(Xu[(2 * jj) * 260], Xu[(2 * jj + 1) * 260]); ko[jj] = (unsigned)Kd[(2 * jj) * 136] | ((unsigned)Kd[(2 * jj + 1) * 136] << 16); }
      const size_t off = (row0 + (e >> 1)) * 1024 + h * 128 + (e & 1) * 64 + jg * 16;
      if (!dry) { v4u* pu = (v4u*)(GV + off); pu[0] = (v4u){uo[0], uo[1], uo[2], uo[3]}; pu[1] = (v4u){uo[4], uo[5], uo[6], uo[7]};
      v4u* pk = (v4u*)(GK + off); pk[0] = (v4u){ko[0], ko[1], ko[2], ko[3]}; pk[1] = (v4u){ko[4], ko[5], ko[6], ko[7]}; } }
    { const v4u v = *(const LAS v4u*)(lds + GL_AQ + r * 144 + cgp * 16); if (!dry) *(v4u*)(AQK + (row0 + r) * 512 + h * 64 + cgp * 8) = v; }
    LDS_BAR();
}

__device__ __forceinline__ void gdn_local_phase(const Ctx& C, const Args& a, bool dry) {
    int s = 0;
    for (int seg = C.bid; seg < 256; seg += C.G, ++s) {
        const int b = seg >> 5, h = (seg >> 2) & 7, qt = seg & 3, c0 = qt * 8;
        for (int c = c0; c < c0 + 8; ++c) {
            const LAS unsigned char* hin = (c == c0) ? (C.lds + GL_SEGH + s * 2304) : (C.lds + GL_HALO + (c & 1) * 2304);
            LAS unsigned char* hout = C.lds + GL_HALO + ((c + 1) & 1) * 2304;
            gdn_local_task(C, a, b, h, c, hin, hout, dry);
        }
    }
}

constexpr int GS_ST = 0  , GS_VN = 34816  , GS_OS = 53248  ;
__device__ __forceinline__ void gdn_scan_phase(const Ctx& C, const Args& a, int bh0, int bhstride) {
    int tid_ = C.tid; asm volatile("" : "+v"(tid_)); const int tid = tid_, lane = tid & 63, wave = C.wave, fr = lane & 15, fq = lane >> 4;
    const bf16* GQ = (const bf16*)(C.ws + B_GQ); const bf16* GK = (const bf16*)(C.ws + B_GK); const bf16* GV = (const bf16*)(C.ws + B_GV); const bf16* GZ = (const bf16*)(C.ws + B_GZ);
    const bf16* WB = (const bf16*)(C.ws + B_WB); const bf16* AQK = (const bf16*)(C.ws + B_AQK); const float* GLs = (const float*)(C.ws + WS_GL);
    bf16* OG = (bf16*)a.out;
    unsigned* prog = (unsigned*)(C.ws + 16384);
    LAS unsigned char* lds = C.lds;
    const int rt = wave >> 1, chh = wave & 1;
    const int r = tid >> 3, cgp = tid & 7;
    f32x4 gno[4];
#pragma unroll
    for (int q4 = 0; q4 < 4; ++q4) gno[q4] = *(const f32x4*)(a.in[6] + cgp * 16 + q4 * 4);
    for (int bh = bh0; bh < 64; bh += bhstride) {
        const int b = bh >> 3, h = bh & 7;
        f32x4 S[8];
#pragma unroll
        for (int t = 0; t < 8; ++t) S[t] = (f32x4){0.f, 0.f, 0.f, 0.f};
        for (int i = tid; i < 34816 / 4; i += NTHR) ((LAS unsigned*)(lds + GS_ST))[i] = 0u;
        __syncthreads();
        bf16x8 wA[4], qA[4], aq[2], kdA[2]; v2u uraw[4]; v4u zc[2]; float glc;
#define SCAN_LD_WQ(cc) do { const size_t row0n = (size_t)b * SEQL + (size_t)(cc) * 64; const size_t o = (row0n + rt * 16 + fr) * 1024 + h * 128 + fq * 8; \
            _Pragma("unroll") for (int ks = 0; ks < 4; ++ks) { wA[ks] = *(const bf16x8*)(WB + o + ks * 32); qA[ks] = *(const bf16x8*)(GQ + o + ks * 32); } } while (0)
#define SCAN_LD_U(cc) do { const size_t row0n = (size_t)b * SEQL + (size_t)(cc) * 64; \
            _Pragma("unroll") for (int t = 0; t < 4; ++t) { const int e = (chh * 4 + t) * 16 + fr; uraw[t] = *(const v2u*)(GV + (row0n + (e >> 1)) * 1024 + h * 128 + (e & 1) * 64 + rt * 16 + 4 * fq); } } while (0)
#define SCAN_LD_AK(cc) do { const size_t row0n = (size_t)b * SEQL + (size_t)(cc) * 64; \
            const size_t oa = (row0n + rt * 16 + fr) * 512 + h * 64 + fq * 8; aq[0] = *(const bf16x8*)(AQK + oa); aq[1] = *(const bf16x8*)(AQK + oa + 32); \
            const int d = wave * 16 + fr; const size_t ok = (row0n + (d >> 1)) * 1024 + h * 128 + (d & 1) * 64 + fq * 8; kdA[0] = *(const bf16x8*)(GK + ok); kdA[1] = *(const bf16x8*)(GK + ok + 32); \
            glc = GLs[bh * 32 + (cc)]; } while (0)
#define SCAN_LD_Z(cc) do { const size_t row0n = (size_t)b * SEQL + (size_t)(cc) * 64; const size_t oz = (row0n + r) * 1024 + h * 128 + cgp * 16; zc[0] = *(const v4u*)(GZ + oz); zc[1] = *(const v4u*)(GZ + oz + 8); } while (0)
        SCAN_LD_WQ(0); SCAN_LD_U(0); SCAN_LD_AK(0); SCAN_LD_Z(0);
        for (int c = 0; c < 32; ++c) {
            const size_t row0 = (size_t)b * SEQL + (size_t)c * 64;
            const int cn = (c + 1 < 32) ? c + 1 : c;
            f32x4 QS[4];
#pragma unroll
            for (int hb = 0; hb < 2; ++hb) { bf16x8 bs[2][4];
#pragma unroll
              for (int t2 = 0; t2 < 2; ++t2)
#pragma unroll
                  for (int ks = 0; ks < 4; ++ks) bs[t2][ks] = *(const LAS bf16x8*)(lds + GS_ST + ((chh * 4 + hb * 2 + t2) * 16 + fr) * 272 + ks * 64 + fq * 16);
              asm volatile("s_waitcnt lgkmcnt(0)" ::: "memory");
#pragma unroll
              for (int t2 = 0; t2 < 2; ++t2) { const int t = hb * 2 + t2; f32x4 WS = (f32x4){0.f, 0.f, 0.f, 0.f}; QS[t] = (f32x4){0.f, 0.f, 0.f, 0.f};
                  const int ct = chh * 4 + t;
#pragma unroll
                  for (int ks = 0; ks < 4; ++ks) {
                      WS = __builtin_amdgcn_mfma_f32_16x16x32_bf16(wA[ks], bs[t2][ks], WS, 0, 0, 0);
                      QS[t] = __builtin_amdgcn_mfma_f32_16x16x32_bf16(qA[ks], bs[t2][ks], QS[t], 0, 0, 0); }
                  const float v0 = bflo(uraw[t].x) - WS[0], v1 = bfhi(uraw[t].x) - WS[1], v2 = bflo(uraw[t].y) - WS[2], v3 = bfhi(uraw[t].y) - WS[3];
                  *(LAS v2u*)(lds + GS_VN + (ct * 16 + fr) * 144 + (rt * 16 + 4 * fq) * 2) = (v2u){pk2(v0, v1), pk2(v2, v3)}; } }
            SCAN_LD_WQ(cn); SCAN_LD_U(cn);
            LDS_BAR();
#pragma unroll
            for (int hb = 0; hb < 2; ++hb) { bf16x8 bv[4][2];
#pragma unroll
              for (int t4 = 0; t4 < 4; ++t4)
#pragma unroll
                  for (int ks = 0; ks < 2; ++ks) bv[t4][ks] = *(const LAS bf16x8*)(lds + GS_VN + ((((chh + hb) & 1) * 4 + t4) * 16 + fr) * 144 + ks * 64 + fq * 16);
              asm volatile("s_waitcnt lgkmcnt(0)" ::: "memory");
              if (hb == 0) {
#pragma unroll
                  for (int t = 0; t < 4; ++t) { const int ct = chh * 4 + t;
#pragma unroll
                      for (int ks = 0; ks < 2; ++ks) QS[t] = __builtin_amdgcn_mfma_f32_16x16x32_bf16(aq[ks], bv[t][ks], QS[t], 0, 0, 0);
#pragma unroll
                      for (int rg = 0; rg < 4; ++rg) ((LAS float*)(lds + GS_OS))[(rt * 16 + 4 * fq + rg) * 132 + ct * 16 + fr] = QS[t][rg]; } }
#pragma unroll
              for (int t4 = 0; t4 < 4; ++t4) { const int t = hb * 4 + t4; const int et = ((chh + hb) & 1) * 4 + t4; S[t] = S[t] * glc;
#pragma unroll
                  for (int ks = 0; ks < 2; ++ks) S[t] = __builtin_amdgcn_mfma_f32_16x16x32_bf16(kdA[ks], bv[t4][ks], S[t], 0, 0, 0);
                  *(LAS v2u*)(lds + GS_ST + (et * 16 + fr) * 272 + (wave * 16 + 4 * fq) * 2) = (v2u){pk2(S[t][0], S[t][1]), pk2(S[t][2], S[t][3])}; } }
            SCAN_LD_AK(cn);
            LDS_BAR();
            if (tid == 0) __hip_atomic_store(prog + bh * 16, (unsigned)(c + 1), __ATOMIC_RELAXED, __HIP_MEMORY_SCOPE_AGENT);
            { const LAS float* os = (const LAS float*)(lds + GS_OS) + r * 132 + cgp * 16;
              float o[16]; float ss = 0.f;
#pragma unroll
              for (int q4 = 0; q4 < 4; ++q4) { const f32x4 v = *(const LAS f32x4*)(os + 4 * q4); o[4 * q4] = v.x; o[4 * q4 + 1] = v.y; o[4 * q4 + 2] = v.z; o[4 * q4 + 3] = v.w; ss += (v.x * v.x + v.y * v.y) + (v.z * v.z + v.w * v.w); }
              ss += __shfl_xor(ss, 1); ss += __shfl_xor(ss, 2); ss += __shfl_xor(ss, 4);
              const float rstd = 1.f / sqrtf(ss * (1.f / 128.f) + EPS);
              const size_t off = (row0 + r) * 1024 + h * 128 + cgp * 16;
              float zf[16]; unpack8(zc[0], zf); unpack8(zc[1], zf + 8);
              SCAN_LD_Z(cn);
#pragma unroll
              for (int e = 0; e < 16; ++e) o[e] = o[e] * rstd * gno[e >> 2][e & 3] * siluf_(zf[e]);
              v4u o0, o1; o0.x = pk2(o[0], o[1]); o0.y = pk2(o[2], o[3]); o0.z = pk2(o[4], o[5]); o0.w = pk2(o[6], o[7]); o1.x = pk2(o[8], o[9]); o1.y = pk2(o[10], o[11]); o1.z = pk2(o[12], o[13]); o1.w = pk2(o[14], o[15]);
              v4u* p = (v4u*)(OG + off); p[0] = o0; p[1] = o1; }
        }
        __syncthreads();
    }
}

__device__ __forceinline__ void attn_phase(const Ctx& C, char* shm, const void* vbuf) {
    const attn_body::bf16* Q = (const attn_body::bf16*)(C.ws + B_Q); const attn_body::bf16* K = (const attn_body::bf16*)(C.ws + B_K); const attn_body::bf16* V = (const attn_body::bf16*)vbuf;
    const int vcu = (C.G % 8 == 0) ? (C.bid % 8) * (C.G / 8) + C.bid / 8 : C.bid;
    for (int tr = vcu; tr < 256; tr += C.G) {
        const int b = tr >> 5, hp = (tr >> 1) & 15, vh = tr & 1, hd = hp >> 1, mp = hp & 1;
        attn_body::bf16* O = (attn_body::bf16*)(C.ws + (mp ? B_O2 : B_O1));
        for (int qb = 7; qb >= 0; --qb) attn_body::attn_unit<8>(b, hp, qb, hd * 128 + vh * 64, hd * 128 + vh * 64, Q, K, V, O, shm);
    }
}
__device__ __forceinline__ void combine_phase(const Ctx& C, const Args& a) {
    float lam;
    { const float p1 = wave_sum(a.in[7][C.lane] * a.in[8][C.lane]), p2 = wave_sum(a.in[9][C.lane] * a.in[10][C.lane]); lam = __expf(p1) - __expf(p2) + 0.2f; }
    const bf16* O1 = (const bf16*)(C.ws + B_O1); const bf16* O2 = (const bf16*)(C.ws + B_O2); bf16* OD = (bf16*)(C.ws + B_Q);
    const int cgp = C.tid & 7;
    f32x4 sg[4];
#pragma unroll
    for (int q4 = 0; q4 < 4; ++q4) sg[q4] = *(const f32x4*)(a.in[11] + cgp * 16 + q4 * 4);
    for (size_t it = (size_t)C.bid * NTHR + C.tid; it < (size_t)M * 64; it += (size_t)C.G * NTHR) {
        const size_t off = (it >> 3) * 128 + cgp * 16;
        float f1[16], f2[16];
        unpack8(*(const v4u*)(O1 + off), f1); unpack8(*(const v4u*)(O1 + off + 8), f1 + 8); unpack8(*(const v4u*)(O2 + off), f2); unpack8(*(const v4u*)(O2 + off + 8), f2 + 8);
        float ss = 0.f;
#pragma unroll
        for (int e = 0; e < 16; ++e) { f1[e] -= lam * f2[e]; ss += f1[e] * f1[e]; }
        ss += __shfl_xor(ss, 1); ss += __shfl_xor(ss, 2); ss += __shfl_xor(ss, 4);
        const float rstd = 0.8f / sqrtf(ss * (1.f / 128.f) + EPS);
#pragma unroll
        for (int e = 0; e < 16; ++e) f1[e] = f1[e] * rstd * sg[e >> 2][e & 3];
        v4u o0, o1; o0.x = pk2(f1[0], f1[1]); o0.y = pk2(f1[2], f1[3]); o0.z = pk2(f1[4], f1[5]); o0.w = pk2(f1[6], f1[7]); o1.x = pk2(f1[8], f1[9]); o1.y = pk2(f1[10], f1[11]); o1.z = pk2(f1[12], f1[13]); o1.w = pk2(f1[14], f1[15]);
        *(v4u*)(OD + off) = o0; *(v4u*)(OD + off + 8) = o1;
    }
}

__device__ __forceinline__ void post_mix_phase(const Ctx& C, const Args& a) {
    const int gw = C.bid * NWAVES + C.wave, NGW = C.G * NWAVES;
    f32x4 g1[4], g2[4];
#pragma unroll
    for (int j = 0; j < 4; ++j) { g1[j] = ((const f32x4*)a.in[15])[C.lane + 64 * j]; g2[j] = ((const f32x4*)a.in[16])[C.lane + 64 * j]; }
    bf16* XN = (bf16*)(C.ws + WS_XN);
    for (int m = gw; m < M; m += NGW) {
        f32x4* mr = (f32x4*)(a.out + (size_t)m * D) + C.lane; const f32x4* xr = (const f32x4*)(a.in[0] + (size_t)m * D) + C.lane;
        const v2u* mb = (const v2u*)((const bf16*)(C.ws + B_F) + (size_t)m * D) + C.lane;
        f32x4 v[4]; float s2 = 0.f;
#pragma unroll
        for (int j = 0; j < 4; ++j) { const v2u w = mb[64 * j]; v[j] = (f32x4){bflo(w.x), bfhi(w.x), bflo(w.y), bfhi(w.y)}; s2 += (v[j].x * v[j].x + v[j].y * v[j].y) + (v[j].z * v[j].z + v[j].w * v[j].w); }
        const float rstd = 1.f / sqrtf(wave_sum(s2) * (1.f / D) + EPS);
        float t2 = 0.f;
#pragma unroll
        for (int j = 0; j < 4; ++j) { v[j] = xr[64 * j] + v[j] * rstd * g1[j]; mr[64 * j] = v[j]; t2 += (v[j].x * v[j].x + v[j].y * v[j].y) + (v[j].z * v[j].z + v[j].w * v[j].w); }
        const float rstd2 = 1.f / sqrtf(wave_sum(t2) * (1.f / D) + EPS);
        unsigned long long* o8 = (unsigned long long*)(XN + (size_t)m * D) + C.lane;
#pragma unroll
        for (int j = 0; j < 4; ++j) { const f32x4 hh = v[j] * rstd2 * g2[j]; o8[64 * j] = (unsigned long long)pk2(hh.x, hh.y) | ((unsigned long long)pk2(hh.z, hh.w) << 32); }
    }
}
__device__ __forceinline__ void final_phase(const Ctx& C, const Args& a) {
    const int gw = C.bid * NWAVES + C.wave, NGW = C.G * NWAVES;
    f32x4 g1[4];
#pragma unroll
    for (int j = 0; j < 4; ++j) g1[j] = ((const f32x4*)a.in[21])[C.lane + 64 * j];
    for (int m = gw; m < M; m += NGW) {
        f32x4* orow = (f32x4*)(a.out + (size_t)m * D) + C.lane; const v2u* fb = (const v2u*)((const bf16*)(C.ws + B_F) + (size_t)m * D) + C.lane;
        f32x4 v[4]; float s2 = 0.f;
#pragma unroll
        for (int j = 0; j < 4; ++j) { const v2u w = fb[64 * j]; v[j] = (f32x4){bflo(w.x), bfhi(w.x), bflo(w.y), bfhi(w.y)}; s2 += (v[j].x * v[j].x + v[j].y * v[j].y) + (v[j].z * v[j].z + v[j].w * v[j].w); }
        const float rstd = 1.f / sqrtf(wave_sum(s2) * (1.f / D) + EPS);
#pragma unroll
        for (int j = 0; j < 4; ++j) orow[64 * j] = orow[64 * j] + v[j] * rstd * g1[j];
    }
}
__device__ __forceinline__ void ffn_conv_phase(const Ctx& C, const Args& a, int hf) {
    const bf16* U = (const bf16*)(C.ws + B_U); bf16* ACT = (bf16*)(C.ws + B_ACT);
    const float* cw = a.in[18]; const float* cb = a.in[19];
    for (size_t it = (size_t)C.bid * NTHR + C.tid; it < (size_t)M * 176; it += (size_t)C.G * NTHR) {
        const size_t row = it / 176; const int rem = (int)(it % 176), tl = rem >> 4, lg = rem & 15;
        const int t = (int)(row & (SEQL - 1));
        const int f0 = (hf * 11 + tl) * 128 + lg * 8;
        float ag[8], au[8];
        { const f32x4 b0 = *(const f32x4*)(cb + f0), b1 = *(const f32x4*)(cb + f0 + 4), c0 = *(const f32x4*)(cb + FF + f0), c1 = *(const f32x4*)(cb + FF + f0 + 4);
          ag[0] = b0.x; ag[1] = b0.y; ag[2] = b0.z; ag[3] = b0.w; ag[4] = b1.x; ag[5] = b1.y; ag[6] = b1.z; ag[7] = b1.w;
          au[0] = c0.x; au[1] = c0.y; au[2] = c0.z; au[3] = c0.w; au[4] = c1.x; au[5] = c1.y; au[6] = c1.z; au[7] = c1.w; }
#pragma unroll
        for (int j = 0; j < 3; ++j) { const int dt = 2 - j;
            if (t >= dt) { const bf16* up = U + (row - dt) * 2816 + tl * 256 + lg * 8;
                float fg[8], fu[8]; unpack8(*(const v4u*)up, fg); unpack8(*(const v4u*)(up + 128), fu);
                const f32x4 w0 = *(const f32x4*)(cw + j * 2 * FF + f0), w1 = *(const f32x4*)(cw + j * 2 * FF + f0 + 4), x0 = *(const f32x4*)(cw + j * 2 * FF + FF + f0), x1 = *(const f32x4*)(cw + j * 2 * FF + FF + f0 + 4);
                ag[0] += w0.x * fg[0]; ag[1] += w0.y * fg[1]; ag[2] += w0.z * fg[2]; ag[3] += w0.w * fg[3]; ag[4] += w1.x * fg[4]; ag[5] += w1.y * fg[5]; ag[6] += w1.z * fg[6]; ag[7] += w1.w * fg[7];
                au[0] += x0.x * fu[0]; au[1] += x0.y * fu[1]; au[2] += x0.z * fu[2]; au[3] += x0.w * fu[3]; au[4] += x1.x * fu[4]; au[5] += x1.y * fu[5]; au[6] += x1.z * fu[6]; au[7] += x1.w * fu[7]; } }
        v4u o; o.x = pk2(siluf_(ag[0]) * au[0], siluf_(ag[1]) * au[1]); o.y = pk2(siluf_(ag[2]) * au[2], siluf_(ag[3]) * au[3]); o.z = pk2(siluf_(ag[4]) * au[4], siluf_(ag[5]) * au[5]); o.w = pk2(siluf_(ag[6]) * au[6], siluf_(ag[7]) * au[7]);
        *(v4u*)(ACT + row * FF + f0) = o;
    }
}

constexpr int NPHASE = 15;
__global__ void __launch_bounds__(NTHR, 2) mk_fwd(Args args) {
    extern __shared__ __attribute__((aligned(16))) unsigned char lds_raw[];
    Ctx C; C.lds = (LAS unsigned char*)lds_raw; C.ws = args.ws; C.tid = threadIdx.x; C.lane = C.tid & 63; C.wave = __builtin_amdgcn_readfirstlane(C.tid >> 6); C.G = gridDim.x; C.bid = blockIdx.x;
    cg::grid_group grid = cg::this_grid();
    const int lo = args.ph_lo, hi = args.ph_hi;
    unsigned char* ws = args.ws;
#ifndef PH_MASK
#define PH_MASK 0xFFFFFFFFu
#endif
#ifndef DUP_MASK
#define DUP_MASK 0u
#endif
#define NREP(k) (((DUP_MASK >> (k)) & 1u) ? 2 : 1)
#define IN(k) (((PH_MASK >> (k)) & 1u) && lo <= (k) && (k) < hi)
    if (C.tid < 4) ((LAS unsigned*)(C.lds + 159808))[C.tid] = 0u;
    __syncthreads();
    XcdBarrier bar = xcd_barrier_post((unsigned*)ws, (volatile LAS unsigned*)(C.lds + 159808));
    if (args.ph_lo > 1000) grid.sync();
#define SEAM(k) do { if (IN(k) && IN((k) + 1)) xcd_barrier(bar); } while (0)
    typedef pg8::EpiBf16<0> EB;
    if (IN(0)) for (int rep_ = 0; rep_ < NREP(0); ++rep_) { p0_prologue(C, args); }
    SEAM(0);
    if (IN(1)) for (int rep_ = 0; rep_ < NREP(1); ++rep_) { pg8::Gemm g{(const bf16*)(ws + WS_XN), (const bf16*)(ws + WS_WING), M, 4096, D}; pg8::StaticOrder S; S.init(M, 4096, C.G, C.bid);
        EB E{(bf16*)(ws + B_GQ), 1024, nullptr, 1024, (size_t)(16 * MiB), 1.f};
        pg8::gemm_phase<EB, pg8::StaticOrder, true, true>(C.lds, g, S, E); } SEAM(1);
    if (IN(2)) for (int rep_ = 0; rep_ < NREP(2); ++rep_) { gdn_halo_preload(C); __syncthreads(); } SEAM(2);
    if (IN(3)) for (int rep_ = 0; rep_ < NREP(3); ++rep_) { gdn_local_phase(C, args, rep_ > 0); } SEAM(3);
    if (IN(4)) for (int rep_ = 0; rep_ < NREP(4); ++rep_) {
        if (C.G > 64 && C.bid < 64) gdn_scan_phase(C, args, C.bid, 64);
        else { const int idx = C.G > 64 ? C.bid - 64 : C.bid, cnt = C.G > 64 ? C.G - 64 : C.G;
            if (C.G <= 64) gdn_scan_phase(C, args, C.bid, C.G);
            late_transposes(C, args, idx, cnt);
            pg8::Gemm g{(const bf16*)(ws + WS_XN), (const bf16*)(ws + WS_WINA) + (size_t)2048 * 1024, M, 1024, D}; pg8::StaticOrder S; S.init(M, 1024, cnt, idx);
            EB E{(bf16*)((unsigned char*)args.out + 32 * MiB), 1024, nullptr, 0, 0, 1.f};
            pg8::gemm_phase<EB, pg8::StaticOrder, true, true>(C.lds, g, S, E);
            { pg8::Gemm g2{(const bf16*)(ws + WS_XN), (const bf16*)(ws + WS_WINA), M, 2048, D}; pg8::ChunkOrder S2{cnt, idx};
              pg8::EpiBf16Wait E2{EB{(bf16*)(ws + B_Q), 1024, nullptr, 1024, (size_t)(16 * MiB), attn_body::C2}, (const unsigned*)(ws + 16384)};
              pg8::gemm_phase<pg8::EpiBf16Wait, pg8::ChunkOrder, true, true>(C.lds, g2, S2, E2); } } } SEAM(4);
    if (IN(6)) for (int rep_ = 0; rep_ < NREP(6); ++rep_) { attn_phase(C, (char*)lds_raw, (const unsigned char*)args.out + 32 * MiB); } SEAM(6);
    if (IN(7)) for (int rep_ = 0; rep_ < NREP(7); ++rep_) { combine_phase(C, args);
        pg8::Gemm g{(const bf16*)(ws + WS_XN), (const bf16*)(ws + WS_WINX), M, 2048, D}; pg8::StaticOrder S; S.init(M, 2048, C.G, C.bid);
        EB E{(bf16*)(ws + B_GATES), 2048, nullptr, 0, 0, 1.f};
        pg8::gemm_phase<EB, pg8::StaticOrder, true, true>(C.lds, g, S, E); } SEAM(7);
    if (IN(8)) for (int rep_ = 0; rep_ < NREP(8); ++rep_) { pg8::Gemm g{(const bf16*)args.out, (const bf16*)(ws + WS_WBA), M, 1024, D}; pg8::StaticOrder S; S.init(M, 1024, C.G, C.bid);
        pg8::EpiGate<false> E{(bf16*)(ws + B_MRG), (const bf16*)(ws + B_GATES), 0};
        pg8::gemm_phase<pg8::EpiGate<false>, pg8::StaticOrder, true, true>(C.lds, g, S, E); } SEAM(8);
    if (IN(9)) for (int rep_ = 0; rep_ < NREP(9); ++rep_) { pg8::Gemm g{(const bf16*)(ws + B_Q), (const bf16*)(ws + WS_WBB), M, 1024, D}; pg8::StaticOrder S; S.init(M, 1024, C.G, C.bid);
        pg8::EpiGate<true> E{(bf16*)(ws + B_MRG), (const bf16*)(ws + B_GATES), 1024};
        pg8::gemm_phase<pg8::EpiGate<true>, pg8::StaticOrder, true, true>(C.lds, g, S, E); } SEAM(9);
    if (IN(10)) for (int rep_ = 0; rep_ < NREP(10); ++rep_) { pg8::Gemm g{(const bf16*)(ws + B_MRG), (const bf16*)(ws + WS_WOUT), M, 1024, D}; pg8::StaticOrder S; S.init(M, 1024, C.G, C.bid);
        EB E{(bf16*)(ws + B_F), 1024, nullptr, 0, 0, 1.f};
        pg8::gemm_phase<EB, pg8::StaticOrder, true, true>(C.lds, g, S, E); } SEAM(10);
    if (IN(11)) for (int rep_ = 0; rep_ < NREP(11); ++rep_) { post_mix_phase(C, args); } SEAM(11);
    if (IN(12)) for (int rep_ = 0; rep_ < NREP(12); ++rep_) { pg8::Gemm g{(const bf16*)(ws + WS_XN) - 2 * 1024, (const bf16*)(ws + WS_WUP), 65 * 256, 5632, D, (size_t)254 * 1024 * 2}; pg8::StaticOrder S; S.init(65 * 256, 5632, C.G, C.bid);
        pg8::EpiConvAct E{(bf16*)(ws + B_ACT), args.in[18], args.in[19], C.lds + 131072};
        pg8::gemm_phase<pg8::EpiConvAct, pg8::StaticOrder, true, true>(C.lds, g, S, E); } SEAM(12);
    if (IN(13)) for (int rep_ = 0; rep_ < NREP(13); ++rep_) { pg8::Gemm g{(const bf16*)(ws + B_ACT), (const bf16*)(ws + WS_WDN), M, 1024, FF}; pg8::StaticOrder S; S.init(M, 1024, C.G, C.bid);
        EB E{(bf16*)(ws + B_F), 1024, nullptr, 0, 0, 1.f};
        pg8::gemm_phase<EB, pg8::StaticOrder, true, true>(C.lds, g, S, E); } SEAM(13);
    if (IN(14)) for (int rep_ = 0; rep_ < NREP(14); ++rep_) { final_phase(C, args); }
#undef IN
#undef SEAM
}

extern "C" void kernel_launch(void* const* d_in, const int* in_sizes, int n_in, void* d_out, int out_size, void* d_ws, size_t ws_size, hipStream_t stream) {
    static int grid = 0;
    if (grid == 0) {
        int dev = 0, cus = 0, per_cu = 0;
        hipGetDevice(&dev); hipDeviceGetAttribute(&cus, hipDeviceAttributeMultiprocessorCount, dev);
        hipFuncSetAttribute((const void*)mk_fwd, hipFuncAttributeMaxDynamicSharedMemorySize, LDS_TOTAL);
        hipOccupancyMaxActiveBlocksPerMultiprocessor(&per_cu, (const void*)mk_fwd, NTHR, LDS_TOTAL);
        (void)hipGetLastError();
        if (per_cu < 1) per_cu = 1;
        grid = cus;
        if (grid > 256) grid = 256;
    }
    (void)hipMemsetAsync(d_ws, 0, 32768, stream);
    Args a{};
    for (int i = 0; i < 22; ++i) a.in[i] = (const float*)d_in[i];
    a.out = (float*)d_out; a.ws = (unsigned char*)d_ws;
#if MK_PER_PHASE
    for (int p = 0; p < NPHASE; ++p) { a.ph_lo = p; a.ph_hi = p + 1; hipLaunchKernelGGL(mk_fwd, dim3(grid), dim3(NTHR), LDS_TOTAL, stream, a); }
#else
    a.ph_lo = 0; a.ph_hi = NPHASE;
    void* kargs[] = {&a};
    hipError_t e = hipLaunchCooperativeKernel((const void*)mk_fwd, dim3(grid), dim3(NTHR), kargs, LDS_TOTAL, stream);
    if (e != hipSuccess) fprintf(stderr, "cooperative launch failed: %s (grid %d)\n", hipGetErrorString(e), grid);
#endif
}
```
